# Optimizing an MI355X kernel written in HIP

```python
import math
import jax, jax.numpy as jnp
from jax import lax
import numpy as np

D_MODEL = 2048
BATCH = 4
SEQ = 4096
DEPTH = 1

GRID_W = 64
NA_HEADS = 16
NA_HEAD_DIM = 64
D_NA = NA_HEADS * NA_HEAD_DIM
D_HY = D_MODEL - D_NA
NA_WIN_ROWS_MAX = 8
NA_WIN_COLS = 16
SHORT_CONV_W = 3
FILTER_EMB = 33
FILTER_ORDER = 64
DECAY_TARGET = 1e-2
FAST_DECAY_PCT = 0.3
SLOW_DECAY_PCT = 1.5
D_FF = 5632
FFN_CONV_W = 3
D_IN = 3 * D_NA + 3 * D_HY
N_MOD = 6
EPS = 1e-6

kernel_name = 'hymba_na_hyena_convglu_block'


def rmsnorm(x, g):
    xf = x.astype(jnp.float32)
    y = xf * lax.rsqrt(jnp.mean(xf * xf, axis=-1, keepdims=True) + EPS)
    return (y * g.astype(jnp.float32)).astype(x.dtype)


def dwconv_centred(u, w, b):
    K = w.shape[0]
    pad = K // 2
    L = u.shape[1]
    up = jnp.pad(u, ((0, 0), (pad, pad), (0, 0)))
    out = up[:, 0:L] * w[0]
    for j in range(1, K):
        out = out + up[:, j:j + L] * w[j]
    return out + b


def neighbourhood_attention(q, k, v, rpb):
    B, L, H, Dh = q.shape
    rows = L // GRID_W
    kh = min(NA_WIN_ROWS_MAX, rows)
    q = q.reshape(B, rows, GRID_W, H, Dh)
    k = k.reshape(B, rows, GRID_W, H, Dh)
    v = v.reshape(B, rows, GRID_W, H, Dh)
    r = jnp.arange(rows)
    row_start = jnp.clip(r - kh // 2, 0, rows - kh)
    key_rows = row_start[:, None] + jnp.arange(kh)[None, :]
    kb = k[:, key_rows]
    vb = v[:, key_rows]
    s = jnp.einsum('brqhd,brikhd->bhrqik', q, kb).astype(jnp.float32) * (NA_HEAD_DIM ** -0.5)
    cq = jnp.arange(GRID_W)
    ck = jnp.arange(GRID_W)
    col_start = jnp.clip(cq - NA_WIN_COLS // 2, 0, GRID_W - NA_WIN_COLS)
    col_mask = (ck[None, :] >= col_start[:, None]) & (ck[None, :] < col_start[:, None] + NA_WIN_COLS)
    row_off = key_rows - r[:, None] + (NA_WIN_ROWS_MAX - 1)
    col_off = jnp.clip(ck[None, :] - cq[:, None], -(NA_WIN_COLS - 1), NA_WIN_COLS - 1) + (NA_WIN_COLS - 1)
    bias = rpb[:, row_off[:, None, :, None], col_off[None, :, None, :]]
    s = s + bias.astype(jnp.float32)[None]
    s = jnp.where(col_mask[:, None, :], s, -jnp.inf)
    p = jax.nn.softmax(s.reshape(B, H, rows, GRID_W, kh * GRID_W), axis=-1)
    p = p.reshape(B, H, rows, GRID_W, kh, GRID_W).astype(vb.dtype)
    o = jnp.einsum('bhrqik,brikhd->brqhd', p, vb)
    return o.reshape(B, L, H * Dh)


def hyena_filters(L, w1, b1, w2, b2, w3, b3, w4, freq):
    f32 = jnp.float32
    t = jnp.linspace(0.0, 1.0, L, dtype=f32)[:, None]
    bands = (FILTER_EMB - 1) // 2
    w = 2.0 * math.pi * jnp.arange(L, dtype=f32)[:, None] / L
    fr = jnp.linspace(1e-4, bands - 1, bands, dtype=f32)[None, :]
    z = jnp.concatenate([t, jnp.cos(fr * w), -jnp.sin(fr * w)], axis=-1)
    fq = freq.astype(f32)
    h = jnp.sin(fq * (z @ w1.astype(f32) + b1.astype(f32)))
    h = jnp.sin(fq * (h @ w2.astype(f32) + b2.astype(f32)))
    h = jnp.sin(fq * (h @ w3.astype(f32) + b3.astype(f32)))
    h = (h @ w4.astype(f32)).reshape(L, 2, D_HY)
    max_decay = math.log(DECAY_TARGET) / FAST_DECAY_PCT
    min_decay = math.log(DECAY_TARGET) / SLOW_DECAY_PCT
    deltas = jnp.linspace(min_decay, max_decay, D_HY, dtype=f32)[None, :]
    decay = jnp.exp(-t * jnp.abs(deltas))
    h = h * decay[:, None, :]
    return h[:, 0], h[:, 1]


def bidirectional_fftconv(u, h_fwd, h_bwd):
    L = u.shape[1]
    C = u.shape[2]
    two_sided = jnp.concatenate([h_fwd, jnp.zeros((1, C), jnp.float32), h_bwd[:0:-1]], axis=0)
    k_f = jnp.fft.rfft(two_sided, n=2 * L, axis=0)
    u_f = jnp.fft.rfft(u.astype(jnp.float32), n=2 * L, axis=1)
    y = jnp.fft.irfft(u_f * k_f[None], n=2 * L, axis=1)[:, :L]
    return y.astype(u.dtype)


def hyena_mixer(hy_in, short_w, short_b, w1, b1, w2, b2, w3, b3, w4, freq, d_bias):
    L = hy_in.shape[1]
    uc = dwconv_centred(hy_in, short_w, short_b)
    x0, x1, v = jnp.split(uc, 3, axis=-1)
    h_fwd, h_bwd = hyena_filters(L, w1, b1, w2, b2, w3, b3, w4, freq)
    v = v * x1
    v = bidirectional_fftconv(v, h_fwd, h_bwd) + v * d_bias
    return v * x0


def setup_inputs(seed: int = 0) -> dict:
    key = jax.random.key(seed)
    ks = jax.random.split(key, 32)
    f32 = jnp.float32

    def nrm(k, shape, scale):
        return jax.random.normal(k, shape, f32) * scale

    Lr = DEPTH
    return {
        'x': nrm(ks[0], (BATCH, SEQ, D_MODEL), 1.0),
        'c': nrm(ks[1], (BATCH, D_MODEL), 1.0),
        'w_ada': nrm(ks[2], (Lr, D_MODEL, N_MOD * D_MODEL), 0.5 * D_MODEL ** -0.5),
        'b_ada': nrm(ks[3], (Lr, N_MOD * D_MODEL), 0.02),
        'g_mix': 1.0 + nrm(ks[4], (Lr, D_MODEL), 0.02),
        'w_in': nrm(ks[5], (Lr, D_MODEL, D_IN), D_MODEL ** -0.5),
        'na_rpb': nrm(ks[6], (Lr, NA_HEADS, 2 * NA_WIN_ROWS_MAX - 1, 2 * NA_WIN_COLS - 1), 0.1),
        'hy_short_w': nrm(ks[7], (Lr, SHORT_CONV_W, 3 * D_HY), SHORT_CONV_W ** -0.5),
        'hy_short_b': nrm(ks[8], (Lr, 3 * D_HY), 0.02),
        'hy_filt_w1': nrm(ks[9], (Lr, FILTER_EMB, FILTER_ORDER), FILTER_EMB ** -0.5),
        'hy_filt_b1': nrm(ks[10], (Lr, FILTER_ORDER), 0.02),
        'hy_filt_w2': nrm(ks[11], (Lr, FILTER_ORDER, FILTER_ORDER), FILTER_ORDER ** -0.5),
        'hy_filt_b2': nrm(ks[12], (Lr, FILTER_ORDER), 0.02),
        'hy_filt_w3': nrm(ks[13], (Lr, FILTER_ORDER, FILTER_ORDER), FILTER_ORDER ** -0.5),
        'hy_filt_b3': nrm(ks[14], (Lr, FILTER_ORDER), 0.02),
        'hy_filt_w4': nrm(ks[15], (Lr, FILTER_ORDER, 2 * D_HY), FILTER_ORDER ** -0.5),
        'hy_filt_freq': 1.0 + nrm(ks[16], (Lr, FILTER_ORDER), 0.01),
        'hy_bias': nrm(ks[17], (Lr, D_HY), 0.1),
        'beta_na': 1.0 + nrm(ks[18], (Lr, D_NA), 0.02),
        'beta_hy': 1.0 + nrm(ks[19], (Lr, D_HY), 0.02),
        'w_out': nrm(ks[20], (Lr, D_MODEL, D_MODEL), D_MODEL ** -0.5),
        'g_ffn': 1.0 + nrm(ks[21], (Lr, D_MODEL), 0.02),
        'w_up': nrm(ks[22], (Lr, D_MODEL, 2 * D_FF), D_MODEL ** -0.5),
        'ffn_conv_w': nrm(ks[23], (Lr, FFN_CONV_W, D_FF), FFN_CONV_W ** -0.5),
        'ffn_conv_b': nrm(ks[24], (Lr, D_FF), 0.02),
        'w_down': nrm(ks[25], (Lr, D_FF, D_MODEL), D_FF ** -0.5),
        'g_final': 1.0 + nrm(ks[26], (D_MODEL,), 0.02),
    }


def reference(x, c, w_ada, b_ada, g_mix, w_in, na_rpb, hy_short_w, hy_short_b,
              hy_filt_w1, hy_filt_b1, hy_filt_w2, hy_filt_b2, hy_filt_w3, hy_filt_b3,
              hy_filt_w4, hy_filt_freq, hy_bias, beta_na, beta_hy, w_out, g_ffn,
              w_up, ffn_conv_w, ffn_conv_b, w_down, g_final):
    B, L, _ = x.shape
    cond = jax.nn.silu(c)
    for l in range(DEPTH):
        mod = cond @ w_ada[l] + b_ada[l]
        sh1, sc1, gt1, sh2, sc2, gt2 = jnp.split(mod[:, None, :], N_MOD, axis=-1)
        h = rmsnorm(x, g_mix[l]) * (1.0 + sc1) + sh1
        proj = h @ w_in[l]
        q = proj[..., 0:D_NA].reshape(B, L, NA_HEADS, NA_HEAD_DIM)
        k = proj[..., D_NA:2 * D_NA].reshape(B, L, NA_HEADS, NA_HEAD_DIM)
        v = proj[..., 2 * D_NA:3 * D_NA].reshape(B, L, NA_HEADS, NA_HEAD_DIM)
        hy_in = proj[..., 3 * D_NA:]
        na_out = neighbourhood_attention(q, k, v, na_rpb[l])
        hy_out = hyena_mixer(hy_in, hy_short_w[l], hy_short_b[l],
                             hy_filt_w1[l], hy_filt_b1[l], hy_filt_w2[l], hy_filt_b2[l],
                             hy_filt_w3[l], hy_filt_b3[l], hy_filt_w4[l], hy_filt_freq[l],
                             hy_bias[l])
        merged = jnp.concatenate([rmsnorm(na_out, beta_na[l]), rmsnorm(hy_out, beta_hy[l])], axis=-1)
        x = x + gt1 * (merged @ w_out[l])
        h = rmsnorm(x, g_ffn[l]) * (1.0 + sc2) + sh2
        a, b = jnp.split(h @ w_up[l], 2, axis=-1)
        a = dwconv_centred(a, ffn_conv_w[l], ffn_conv_b[l])
        x = x + gt2 * ((jax.nn.gelu(a, approximate=False) * b) @ w_down[l])
    return rmsnorm(x, g_final)
```

```cpp
#include <hip/hip_runtime.h>
#include <hip/hip_cooperative_groups.h>
#include <cstdio>
#include <cstdint>
namespace cg = cooperative_groups;
namespace pg8 {
#define PG8_LAS __attribute__((address_space(3)))
typedef unsigned short bf16_t;
typedef short bf16x8 __attribute__((ext_vector_type(8)));
typedef float f32x4 __attribute__((ext_vector_type(4)));
typedef unsigned u32x4 __attribute__((ext_vector_type(4)));
constexpr int BM = 256, BK = 64, HALF = 128, HTB = HALF * BK * 2  , STAGE_BYTES = 8 * HTB, NXCD = 8, WGM = 8;

__host__ __device__ __forceinline__ int lds_byte(int r, int c) { const int st = (r >> 4) * 2 + (c >> 5), rr = r & 15, cc = c & 31, ob = rr * 64 + cc * 2; return st * 1024 + (ob ^ (((ob >> 9) & 1) << 5)); }
__host__ __device__ __forceinline__ void stage_rc(int b, int& R, int& C) { const int st = b / 1024, sb = b % 1024, swz = sb ^ (((sb >> 9) & 1) << 5); R = (st >> 1) * 16 + swz / 64; C = (st & 1) * 32 + (swz % 64) / 2; }
__host__ __device__ __forceinline__ int perm32(int rho) { const int n = rho >> 4, i = rho & 15; return 8 * (i >> 2) + 4 * n + (i & 3); }

struct Unit { int pm, pn; };
struct Gemm { const bf16_t* A; const bf16_t* Bt; int M, N, K; };

struct StaticOrder {
    int nM, nN, nwg, G, c;
    __host__ __device__ void init(int M, int N, int G_, int c_) { nM = M / BM; nN = N / BM; nwg = nM * nN; G = G_; c = c_; }
    __host__ __device__ bool next(int i, Unit& u) const {
        const long L = (long)i * G + c; if (L >= nwg) return false;
        int wgid = (int)L; { const int q = nwg / NXCD, r = nwg % NXCD, xcd = wgid % NXCD, off = wgid / NXCD; wgid = (xcd < r ? xcd * (q + 1) : r * (q + 1) + (xcd - r) * q) + off; }
        const int nig = WGM * nN, gid = wgid / nig, fm = gid * WGM, gsz = (nM - fm) < WGM ? (nM - fm) : WGM;
        u.pm = fm + ((wgid % nig) % gsz); u.pn = (wgid % nig) / gsz; return true;
    }
    __device__ __forceinline__ void a_ready(const Unit&) const {}
    __device__ __forceinline__ void done(const Unit&) const {}
};

__device__ __forceinline__ unsigned cvt_pk_bf16(float lo, float hi) { unsigned r; asm volatile("v_cvt_pk_bf16_f32 %0, %1, %2" : "=v"(r) : "v"(lo), "v"(hi)); return r; }
typedef float f32x2 __attribute__((ext_vector_type(2)));
__device__ __forceinline__ f32x2 gelu_pk(f32x2 v) {
    const f32x2 av = __builtin_elementwise_abs(v), d = av * 0.2316418882f + 1.0f;
    f32x2 t; t.x = __builtin_amdgcn_rcpf(d.x); t.y = __builtin_amdgcn_rcpf(d.y);
    f32x2 q = t * 0.5307027145f + (-0.7265760135f); q = q * t + 0.7107068705f; q = q * t + (-0.142248368f); q = q * t + 0.127414796f; q = q * t;
    const f32x2 s = (v * v) * (-0.72134752044f);
    f32x2 e; e.x = __builtin_amdgcn_exp2f(s.x); e.y = __builtin_amdgcn_exp2f(s.y);
    const f32x2 m = v * (q * e), r = v - m;
    f32x2 o; o.x = v.x < 0.f ? m.x : r.x; o.y = v.y < 0.f ? m.y : r.y; return o;
}

template <int ACT  > struct EpiBf16 {
    static constexpr bool PERM = true, AFTER_DRAIN = false; static_assert(ACT == 0 || ACT == 1, "EpiBf16: ACT is 0 (none) or 1 (gelu_pk)");
    bf16_t* O; int ldc; const float* bias; int split_cols; size_t split_stride; float scale0;
    __device__ __forceinline__ void operator()(const f32x4 (&acc)[2][2][4][2], const Unit& u, int wr, int wc, int fr, int fq) const {
        const int row0 = u.pm * BM + wr * 64 + fr; int colt = u.pn * BM; bf16_t* base = O;
        float sc = 1.f; if (split_cols) { const int t = colt / split_cols; base += (size_t)t * split_stride; colt -= t * split_cols; if (t == 0) sc = scale0; }
        const int col0 = colt + wc * 32 + 8 * fq, bcol0 = u.pn * BM + wc * 32 + 8 * fq;
        f32x4 bv[2][2];
#pragma unroll
        for (int bj = 0; bj < 2; ++bj)
#pragma unroll
            for (int n = 0; n < 2; ++n) bv[bj][n] = bias ? *(const f32x4*)(bias + bcol0 + bj * HALF + 4 * n) : (f32x4){0.f, 0.f, 0.f, 0.f};
#pragma unroll
        for (int ai = 0; ai < 2; ++ai)
#pragma unroll
            for (int m = 0; m < 4; ++m) { bf16_t* rowp = base + (size_t)(row0 + ai * HALF + m * 16) * ldc + col0;
#pragma unroll
                for (int bj = 0; bj < 2; ++bj) { f32x4 v0 = acc[ai][bj][m][0] + bv[bj][0], v1 = acc[ai][bj][m][1] + bv[bj][1];
                    if (ACT == 1) { f32x2 a = gelu_pk((f32x2){v0[0], v0[1]}), b = gelu_pk((f32x2){v0[2], v0[3]}), c = gelu_pk((f32x2){v1[0], v1[1]}), d = gelu_pk((f32x2){v1[2], v1[3]});
                        v0 = (f32x4){a.x, a.y, b.x, b.y}; v1 = (f32x4){c.x, c.y, d.x, d.y}; }
                    v0 = v0 * sc; v1 = v1 * sc; u32x4 w; w.x = cvt_pk_bf16(v0[0], v0[1]); w.y = cvt_pk_bf16(v0[2], v0[3]); w.z = cvt_pk_bf16(v1[0], v1[1]); w.w = cvt_pk_bf16(v1[2], v1[3]);
                    *(u32x4*)(rowp + bj * HALF) = w; } }
    }
};

typedef unsigned u32x2 __attribute__((ext_vector_type(2)));
#define PG8_DPP(oldv, src, ctrl, bc) __builtin_bit_cast(float, __builtin_amdgcn_update_dpp(__builtin_bit_cast(int, (float)(oldv)), __builtin_bit_cast(int, (float)(src)), (ctrl), 0xf, 0xf, (bc)))


__device__ __forceinline__ int na_kappa(int x) { return (x & ~12) | ((x & 8) >> 1) | ((x & 4) << 1); }
struct EpiFragQK {
    static constexpr bool PERM = true, AFTER_DRAIN = false;
    bf16_t* O; float scale_q;
    __device__ __forceinline__ void operator()(const f32x4 (&acc)[2][2][4][2], const Unit& u, int wr, int wc, int fr, int fq) const {
#pragma unroll
        for (int bj = 0; bj < 2; ++bj) { const int col8 = u.pn * BM + bj * HALF + wc * 32 + 8 * fq, which = col8 >> 10, h = (col8 >> 6) & 15, d0 = col8 & 63, ds = d0 >> 4, hh = (d0 >> 3) & 1;
            const float sc = which ? 1.f : scale_q;
#pragma unroll
            for (int ai = 0; ai < 2; ++ai)
#pragma unroll
                for (int m = 0; m < 4; ++m) { const int row = u.pm * BM + ai * HALF + wr * 64 + m * 16 + fr, b = row >> 12, r = (row >> 6) & 63, c = row & 63, t32 = c >> 5, c31 = c & 31;
                    const int rho = which ? na_kappa(c31) : c31;
                    const size_t fi = (((((size_t)(which * 4 + b) * 16 + h) * 64 + r) * 2 + t32) * 4 + ds); const size_t addr = fi * 512 + (rho + 32 * hh) * 8;
                    const f32x4 v0 = acc[ai][bj][m][0] * sc, v1 = acc[ai][bj][m][1] * sc;
                    u32x4 w; w.x = cvt_pk_bf16(v0[0], v0[1]); w.y = cvt_pk_bf16(v0[2], v0[3]); w.z = cvt_pk_bf16(v1[0], v1[1]); w.w = cvt_pk_bf16(v1[2], v1[3]);
                    *(u32x4*)(O + addr) = w; } }
    }
};
struct EpiVHy {
    static constexpr bool PERM = true, AFTER_DRAIN = false;
    bf16_t* O; int ldc;
    __device__ __forceinline__ void operator()(const f32x4 (&acc)[2][2][4][2], const Unit& u, int wr, int wc, int fr, int fq) const {
#pragma unroll
        for (int bj = 0; bj < 2; ++bj) { const int col8 = u.pn * BM + bj * HALF + wc * 32 + 8 * fq, b = col8 >> 12, kr = (col8 >> 6) & 63, c = col8 & 63, kt = c >> 5, s2 = (c >> 4) & 1, hh = (c >> 3) & 1;
#pragma unroll
            for (int ai = 0; ai < 2; ++ai)
#pragma unroll
                for (int m = 0; m < 4; ++m) { const int ch = u.pm * BM + ai * HALF + wr * 64 + m * 16 + fr; size_t addr;
                    if (u.pm < 4) { const int h = ch >> 6, d = ch & 63, dt = d >> 5;
                        const size_t fi = (((((size_t)(b * 16 + h) * 64 + kr) * 2 + kt) * 2 + dt) * 2 + s2); addr = fi * 512 + ((d & 31) + 32 * hh) * 8; }
                    else addr = (size_t)ch * ldc + col8;
                    const f32x4 v0 = acc[ai][bj][m][0], v1 = acc[ai][bj][m][1];
                    u32x4 w; w.x = cvt_pk_bf16(v0[0], v0[1]); w.y = cvt_pk_bf16(v0[2], v0[3]); w.z = cvt_pk_bf16(v1[0], v1[1]); w.w = cvt_pk_bf16(v1[2], v1[3]);
                    if (u.pm < 4) *(u32x4*)(O + addr) = w; else __builtin_nontemporal_store(w, (u32x4*)(O + addr)); } }
    }
};
struct EpiRes1 {
    static constexpr bool PERM = true, AFTER_DRAIN = false;
    const float* xin; bf16_t* x1; bf16_t* a2; const float* gate; int gate_stride; const float* gmul; float* ssq; int ldc;
    __device__ __forceinline__ void operator()(const f32x4 (&acc)[2][2][4][2], const Unit& u, int wr, int wc, int fr, int fq) const {
        const int b = u.pm >> 4;
        const int row0 = u.pm * BM + wr * 64 + fr, col0 = u.pn * BM + wc * 32 + 8 * fq;
        f32x4 gv[2][2], mv[2][2];
#pragma unroll
        for (int bj = 0; bj < 2; ++bj)
#pragma unroll
            for (int n = 0; n < 2; ++n) { gv[bj][n] = *(const f32x4*)(gate + (size_t)b * gate_stride + col0 + bj * HALF + n * 4); mv[bj][n] = *(const f32x4*)(gmul + (size_t)b * ldc + col0 + bj * HALF + n * 4); }
#pragma unroll
        for (int ai = 0; ai < 2; ++ai)
#pragma unroll
            for (int m = 0; m < 4; ++m) { const int row = row0 + ai * HALF + m * 16; const size_t off = (size_t)row * ldc + col0; float s = 0.f;
#pragma unroll
                for (int bj = 0; bj < 2; ++bj) { u32x4 w1, w2;
#pragma unroll
                    for (int n = 0; n < 2; ++n) { const f32x4 xv = __builtin_nontemporal_load((const f32x4*)(xin + off + bj * HALF + n * 4)); const f32x4 v = xv + gv[bj][n] * acc[ai][bj][m][n];
                        s += (v[0] * v[0] + v[1] * v[1]) + (v[2] * v[2] + v[3] * v[3]);
                        const f32x4 a = v * mv[bj][n];
                        if (n == 0) { w1.x = cvt_pk_bf16(v[0], v[1]); w1.y = cvt_pk_bf16(v[2], v[3]); w2.x = cvt_pk_bf16(a[0], a[1]); w2.y = cvt_pk_bf16(a[2], a[3]); }
                        else { w1.z = cvt_pk_bf16(v[0], v[1]); w1.w = cvt_pk_bf16(v[2], v[3]); w2.z = cvt_pk_bf16(a[0], a[1]); w2.w = cvt_pk_bf16(a[2], a[3]); } }
                    *(u32x4*)(x1 + off + bj * HALF) = w1; *(u32x4*)(a2 + off + bj * HALF) = w2; }
                s += __shfl_xor(s, 16); s += __shfl_xor(s, 32);
                if (fq == 0) atomicAdd(ssq + row, s);
                asm volatile("" ::: "memory"); }
    }
};
struct EpiRes2 {
    static constexpr bool PERM = true, AFTER_DRAIN = false;
    const bf16_t* x1; bf16_t* x2; const float* gate; int gate_stride; int ldc;
    __device__ __forceinline__ void operator()(const f32x4 (&acc)[2][2][4][2], const Unit& u, int wr, int wc, int fr, int fq) const {
        const int b = u.pm >> 4;
        const int row0 = u.pm * BM + wr * 64 + fr, col0 = u.pn * BM + wc * 32 + 8 * fq;
        f32x4 gv[2][2];
#pragma unroll
        for (int bj = 0; bj < 2; ++bj)
#pragma unroll
            for (int n = 0; n < 2; ++n) gv[bj][n] = *(const f32x4*)(gate + (size_t)b * gate_stride + col0 + bj * HALF + n * 4);
#pragma unroll
        for (int ai = 0; ai < 2; ++ai)
#pragma unroll
            for (int m = 0; m < 4; ++m) { const size_t off = (size_t)(row0 + ai * HALF + m * 16) * ldc + col0;
#pragma unroll
                for (int bj = 0; bj < 2; ++bj) { const u32x4 xw = __builtin_nontemporal_load((const u32x4*)(x1 + off + bj * HALF));
                    const f32x4 xv0 = {__builtin_bit_cast(float, xw.x << 16), __builtin_bit_cast(float, xw.x & 0xffff0000u), __builtin_bit_cast(float, xw.y << 16), __builtin_bit_cast(float, xw.y & 0xffff0000u)};
                    const f32x4 xv1 = {__builtin_bit_cast(float, xw.z << 16), __builtin_bit_cast(float, xw.z & 0xffff0000u), __builtin_bit_cast(float, xw.w << 16), __builtin_bit_cast(float, xw.w & 0xffff0000u)};
                    const f32x4 v0 = xv0 + gv[bj][0] * acc[ai][bj][m][0], v1 = xv1 + gv[bj][1] * acc[ai][bj][m][1];
                    u32x4 w; w.x = cvt_pk_bf16(v0[0], v0[1]); w.y = cvt_pk_bf16(v0[2], v0[3]); w.z = cvt_pk_bf16(v1[0], v1[1]); w.w = cvt_pk_bf16(v1[2], v1[3]);
                    *(u32x4*)(x2 + off + bj * HALF) = w; }
                asm volatile("" ::: "memory"); }
    }
};
struct EpiGlu {
    static constexpr bool PERM = true, AFTER_DRAIN = false;
    bf16_t* gated; const float* ssq; const float* biasU; const float* cw; const float* cb; float* edgeA; float* edgeB; PG8_LAS float* xch; int ldo;
    __device__ __forceinline__ void operator()(f32x4 (&acc)[2][2][4][2], const Unit& u, int wr, int wc, int fr, int fq) const {
        const int b = u.pm >> 4;
        const int lcol0 = wc * 32 + 8 * fq, jcol0 = u.pn * HALF + lcol0;
        {
            f32x4 bu[2][2];
#pragma unroll
            for (int bj = 0; bj < 2; ++bj)
#pragma unroll
                for (int n = 0; n < 2; ++n) bu[bj][n] = *(const f32x4*)(biasU + (size_t)b * 11264 + u.pn * BM + bj * HALF + lcol0 + 4 * n);
#pragma unroll
            for (int ai = 0; ai < 2; ++ai)
#pragma unroll
                for (int m = 0; m < 4; ++m) { const int row = u.pm * BM + ai * HALF + wr * 64 + m * 16 + fr; const float rs = 1.0f / sqrtf(ssq[row] * (1.0f / 2048.0f) + 1e-6f);
#pragma unroll
                    for (int bj = 0; bj < 2; ++bj)
#pragma unroll
                        for (int n = 0; n < 2; ++n) acc[ai][bj][m][n] = acc[ai][bj][m][n] * rs + bu[bj][n]; }
        }
#pragma unroll
        for (int ai = 0; ai < 2; ++ai) { const int seg = 2 * ai + wr;
#pragma unroll
            for (int n = 0; n < 2; ++n) {
                if (fr == 0) *(PG8_LAS f32x4*)(xch + (seg * 2 + 0) * 128 + lcol0 + 4 * n) = acc[ai][0][0][n];
                if (fr == 15) *(PG8_LAS f32x4*)(xch + (seg * 2 + 1) * 128 + lcol0 + 4 * n) = acc[ai][0][3][n];
            } }
        if (wr == 0) {
#pragma unroll
            for (int n = 0; n < 2; ++n) { if (fr < 2) *(f32x4*)(edgeA + ((size_t)u.pm * 4 + fr) * ldo + jcol0 + 4 * n) = acc[0][0][0][n];
                                        if (fr == 0) *(f32x4*)(edgeB + ((size_t)u.pm * 2 + 0) * ldo + jcol0 + 4 * n) = acc[0][1][0][n]; }
        } else {
#pragma unroll
            for (int n = 0; n < 2; ++n) { if (fr >= 14) *(f32x4*)(edgeA + ((size_t)u.pm * 4 + (fr - 12)) * ldo + jcol0 + 4 * n) = acc[1][0][3][n];
                                        if (fr == 15) *(f32x4*)(edgeB + ((size_t)u.pm * 2 + 1) * ldo + jcol0 + 4 * n) = acc[1][1][3][n]; }
        }
        asm volatile("s_waitcnt lgkmcnt(0)" ::: "memory"); __builtin_amdgcn_s_barrier(); asm volatile("" ::: "memory");
        u32x2 w_lo[2][4];
#pragma unroll
        for (int n = 0; n < 2; ++n) {
            const f32x4 w0 = *(const f32x4*)(cw + jcol0 + 4 * n), w1 = *(const f32x4*)(cw + ldo + jcol0 + 4 * n), w2 = *(const f32x4*)(cw + 2 * ldo + jcol0 + 4 * n), cbv = *(const f32x4*)(cb + jcol0 + 4 * n);
#pragma unroll
            for (int ai = 0; ai < 2; ++ai) { const int seg = 2 * ai + wr;
                f32x4 xp = (f32x4){0.f, 0.f, 0.f, 0.f}, xn = (f32x4){0.f, 0.f, 0.f, 0.f};
                if (seg > 0) xp = *(const PG8_LAS f32x4*)(xch + ((seg - 1) * 2 + 1) * 128 + lcol0 + 4 * n);
                if (seg < 3) xn = *(const PG8_LAS f32x4*)(xch + ((seg + 1) * 2 + 0) * 128 + lcol0 + 4 * n);
#pragma unroll
                for (int m = 0; m < 4; ++m) { const f32x4 cur = acc[ai][0][m][n]; f32x4 pv, nv;
#pragma unroll
                    for (int e = 0; e < 4; ++e) {
                        float t0, t1;
                        if (m > 0) t0 = PG8_DPP(0.f, acc[ai][0][m > 0 ? m - 1 : 0][n][e], 0x10F, true); else t0 = (fr == 0) ? xp[e] : 0.f;
                        pv[e] = PG8_DPP(t0, cur[e], 0x111, false);
                        if (m < 3) t1 = PG8_DPP(0.f, acc[ai][0][m < 3 ? m + 1 : 3][n][e], 0x11F, true); else t1 = (fr == 15) ? xn[e] : 0.f;
                        nv[e] = PG8_DPP(t1, cur[e], 0x101, false);
                    }
                    const f32x4 cv = w0 * pv + w1 * cur + w2 * nv + cbv;
                    const f32x2 g0 = gelu_pk((f32x2){cv[0], cv[1]}), g1 = gelu_pk((f32x2){cv[2], cv[3]});
                    const f32x4 bb = acc[ai][1][m][n];
                    u32x2 w; w.x = cvt_pk_bf16(g0.x * bb[0], g0.y * bb[1]); w.y = cvt_pk_bf16(g1.x * bb[2], g1.y * bb[3]);
                    if (n == 0) w_lo[ai][m] = w;
                    else { const int row = u.pm * BM + ai * HALF + wr * 64 + m * 16 + fr;
                        u32x4 o; o.x = w_lo[ai][m].x; o.y = w_lo[ai][m].y; o.z = w.x; o.w = w.y;
                        __builtin_nontemporal_store(o, (u32x4*)(gated + (size_t)row * ldo + jcol0)); } }
            } }
    }
};
template <class Epi, class Sched, bool ALIGN_EPI = false, bool SP2 = false>
__device__ __forceinline__ void gemm_phase(PG8_LAS unsigned char* lds, const Gemm g, const Sched& S, const Epi& E) {
    const int tid = threadIdx.x, wid = __builtin_amdgcn_readfirstlane(tid >> 6), lane = tid & 63, wr = wid >> 2, wc = wid & 3, fr = lane & 15, fq = lane >> 4;
    const int K = g.K, nt = K / BK;
    unsigned voffA[2], voffB[2];
#pragma unroll
    for (int i = 0; i < 2; ++i) { int R, C; stage_rc(tid * 16 + i * 8192, R, C); const int Rb = Epi::PERM ? ((R & ~31) + perm32(R & 31)) : R;
        voffA[i] = (unsigned)(R * K + C) * 2u; voffB[i] = (unsigned)(Rb * K + C) * 2u; }
    const size_t kstep = (size_t)(BK * 2);
    const size_t hstep = (size_t)HALF * K * 2;
    const size_t tstep = 2 * hstep;
    const unsigned ldsw = (unsigned)wid * 1024u;
    const int aoff = lds_byte(wr * 64 + fr, fq * 8), boff = lds_byte(wc * 32 + fr, fq * 8);
#define PG8_SA(b, h) (((b) * 2 + (h)) * HTB)
#define PG8_SB(b, h) ((4 + (b) * 2 + (h)) * HTB)
#define PG8_STAGE(bufoff, gbase, voff) do { _Pragma("unroll") for (int _i = 0; _i < 2; ++_i) \
        __builtin_amdgcn_global_load_lds((const unsigned*)((const char*)(gbase) + (voff)[_i]), (PG8_LAS unsigned*)(lds + (bufoff) + ldsw + _i * 8192), 16, 0, 0); } while (0)
#define PG8_LDA(dst, b, h) do { _Pragma("unroll") for (int m = 0; m < 4; ++m) _Pragma("unroll") for (int k = 0; k < 2; ++k) dst[m][k] = *(const PG8_LAS bf16x8*)(lds + PG8_SA(b, h) + aoff + m * 2048 + k * 1024); } while (0)
#define PG8_LDB(dst, b, h) do { _Pragma("unroll") for (int n = 0; n < 2; ++n) _Pragma("unroll") for (int k = 0; k < 2; ++k) dst[n][k] = *(const PG8_LAS bf16x8*)(lds + PG8_SB(b, h) + boff + n * 2048 + k * 1024); } while (0)
#define PG8_MMA(ai, bj, At, Bt) do { __builtin_amdgcn_s_setprio(1); _Pragma("unroll") for (int m = 0; m < 4; ++m) _Pragma("unroll") for (int n = 0; n < 2; ++n) _Pragma("unroll") for (int k = 0; k < 2; ++k) \
        acc[ai][bj][m][n] = __builtin_amdgcn_mfma_f32_16x16x32_bf16(Bt[n][k], At[m][k], acc[ai][bj][m][n], 0, 0, 0); __builtin_amdgcn_s_setprio(0); } while (0)
#define PG8_WAIT_V(n) asm volatile("s_waitcnt vmcnt(" #n ")" ::: "memory")
#define PG8_WAIT_L(n) asm volatile("s_waitcnt lgkmcnt(" #n ")" ::: "memory")
#define PG8_BAR __builtin_amdgcn_s_barrier()
#define PG8_SCHED __builtin_amdgcn_sched_barrier(0)
    Unit cur, nxt; int ui = 0;
    if (!S.next(0, cur)) return;
    f32x4 acc[2][2][4][2];
#pragma unroll
    for (int a = 0; a < 2; ++a)
#pragma unroll
        for (int b = 0; b < 2; ++b)
#pragma unroll
            for (int m = 0; m < 4; ++m)
#pragma unroll
                for (int n = 0; n < 2; ++n) acc[a][b][m][n] = (f32x4){0.f, 0.f, 0.f, 0.f};
    bf16x8 At[4][2], B0[2][2], B1[2][2];
    const char* cA = (const char*)g.A + (size_t)cur.pm * tstep; const char* cB = (const char*)g.Bt + (size_t)cur.pn * tstep;
    S.a_ready(cur);
    if constexpr (SP2) {
        PG8_STAGE(PG8_SB(0, 0), cB, voffB); PG8_STAGE(PG8_SB(0, 1), cB + hstep, voffB); PG8_STAGE(PG8_SA(0, 0), cA, voffA); PG8_STAGE(PG8_SA(0, 1), cA + hstep, voffA);
        if (wr == 1) PG8_BAR;
        PG8_WAIT_V(2); PG8_BAR;
        PG8_STAGE(PG8_SB(1, 0), cB + kstep, voffB); PG8_STAGE(PG8_SA(1, 0), cA + kstep, voffA); PG8_STAGE(PG8_SB(1, 1), cB + hstep + kstep, voffB);
        PG8_WAIT_V(6); PG8_BAR;
    } else {
        PG8_STAGE(PG8_SB(0, 0), cB, voffB); PG8_STAGE(PG8_SA(0, 0), cA, voffA); PG8_STAGE(PG8_SB(0, 1), cB + hstep, voffB); PG8_STAGE(PG8_SA(0, 1), cA + hstep, voffA);
        if (wr == 1) PG8_BAR;
        PG8_WAIT_V(4); PG8_BAR;
        PG8_STAGE(PG8_SB(1, 0), cB + kstep, voffB); PG8_STAGE(PG8_SA(1, 0), cA + kstep, voffA); PG8_STAGE(PG8_SB(1, 1), cB + hstep + kstep, voffB);
        PG8_WAIT_V(6); PG8_BAR;
    }
    for (;;) {
        const bool has_next = S.next(ui + 1, nxt);
        const char* nA = has_next ? (const char*)g.A + (size_t)nxt.pm * tstep : cA; const char* nB = has_next ? (const char*)g.Bt + (size_t)nxt.pn * tstep : cB;
        for (int t = 0; t < nt; t += 2) {
            const bool last = (t == nt - 2);
            const char* a1 = cA + (size_t)(t + 1) * kstep;
            const char* a2 = last ? nA : cA + (size_t)(t + 2) * kstep; const char* b2 = last ? nB : cB + (size_t)(t + 2) * kstep;
            const char* a3 = a2 + kstep; const char* b3 = b2 + kstep;
            if (last && has_next) S.a_ready(nxt);
            if constexpr (SP2) {
            PG8_LDB(B0, 0, 0); PG8_LDB(B1, 0, 1); PG8_SCHED; PG8_LDA(At, 0, 0); PG8_STAGE(PG8_SA(1, 1), a1 + hstep, voffA);
            PG8_WAIT_V(8); PG8_WAIT_L(0); PG8_BAR; PG8_MMA(0, 0, At, B0); PG8_MMA(0, 1, At, B1); PG8_BAR; PG8_SCHED;
            PG8_LDA(At, 0, 1); PG8_STAGE(PG8_SB(0, 0), b2, voffB); PG8_STAGE(PG8_SB(0, 1), b2 + hstep, voffB); PG8_STAGE(PG8_SA(0, 0), a2, voffA);
            PG8_WAIT_V(8); PG8_WAIT_L(0); PG8_BAR; PG8_MMA(1, 0, At, B0); PG8_MMA(1, 1, At, B1); PG8_BAR; PG8_SCHED;
            PG8_LDB(B0, 1, 0); PG8_LDB(B1, 1, 1); PG8_SCHED; PG8_LDA(At, 1, 0); PG8_STAGE(PG8_SA(0, 1), a2 + hstep, voffA);
            PG8_WAIT_V(8); PG8_WAIT_L(0); PG8_BAR; PG8_MMA(0, 0, At, B0); PG8_MMA(0, 1, At, B1); PG8_BAR; PG8_SCHED;
            PG8_LDA(At, 1, 1); PG8_STAGE(PG8_SB(1, 0), b3, voffB); PG8_STAGE(PG8_SB(1, 1), b3 + hstep, voffB); PG8_STAGE(PG8_SA(1, 0), a3, voffA);
            PG8_WAIT_V(8); PG8_WAIT_L(0); PG8_BAR; PG8_MMA(1, 0, At, B0); PG8_MMA(1, 1, At, B1); PG8_BAR; PG8_SCHED;
            } else {
            PG8_LDB(B0, 0, 0); PG8_SCHED; PG8_LDA(At, 0, 0); PG8_STAGE(PG8_SA(1, 1), a1 + hstep, voffA);
            PG8_WAIT_L(8); PG8_BAR; PG8_WAIT_L(0); PG8_MMA(0, 0, At, B0); PG8_BAR; PG8_SCHED;
            PG8_LDB(B1, 0, 1); PG8_STAGE(PG8_SB(0, 0), b2, voffB);
            PG8_BAR; PG8_WAIT_L(0); PG8_MMA(0, 1, At, B1); PG8_BAR;
            PG8_LDA(At, 0, 1); PG8_STAGE(PG8_SA(0, 0), a2, voffA);
            PG8_BAR; PG8_WAIT_L(0); PG8_MMA(1, 0, At, B0); PG8_BAR; PG8_SCHED;
            PG8_STAGE(PG8_SB(0, 1), b2 + hstep, voffB);
            PG8_WAIT_V(6); PG8_BAR; PG8_MMA(1, 1, At, B1); PG8_BAR;
            PG8_LDB(B0, 1, 0); PG8_SCHED; PG8_LDA(At, 1, 0); PG8_STAGE(PG8_SA(0, 1), a2 + hstep, voffA);
            PG8_WAIT_L(8); PG8_BAR; PG8_WAIT_L(0); PG8_MMA(0, 0, At, B0); PG8_BAR; PG8_SCHED;
            PG8_LDB(B1, 1, 1); PG8_STAGE(PG8_SB(1, 0), b3, voffB);
            PG8_BAR; PG8_WAIT_L(0); PG8_MMA(0, 1, At, B1); PG8_BAR;
            PG8_LDA(At, 1, 1); PG8_STAGE(PG8_SA(1, 0), a3, voffA);
            PG8_BAR; PG8_WAIT_L(0); PG8_MMA(1, 0, At, B0); PG8_BAR; PG8_SCHED;
            PG8_STAGE(PG8_SB(1, 1), b3 + hstep, voffB);
            PG8_WAIT_V(6); PG8_BAR; PG8_MMA(1, 1, At, B1); PG8_BAR;
            }
        }
        if constexpr (ALIGN_EPI) { if (wr == 0) PG8_BAR; }
        if constexpr (!Epi::AFTER_DRAIN) { E(acc, cur, wr, wc, fr, fq); S.done(cur); }
        if (!has_next) break;
#pragma unroll
        for (int a = 0; a < 2; ++a)
#pragma unroll
            for (int b = 0; b < 2; ++b)
#pragma unroll
                for (int m = 0; m < 4; ++m)
#pragma unroll
                    for (int n = 0; n < 2; ++n) acc[a][b][m][n] = (f32x4){0.f, 0.f, 0.f, 0.f};
        cur = nxt; cA = nA; cB = nB; ++ui;
        if constexpr (ALIGN_EPI) { if (wr == 1) PG8_BAR; }
    }
    PG8_WAIT_V(0);
    if constexpr (!ALIGN_EPI) { if (wr == 0) PG8_BAR; }
    PG8_BAR;
    if constexpr (Epi::AFTER_DRAIN) { E.fused(acc, cur, wr, wc, fr, fq, lds, wid, lane); S.done(cur); }
#undef PG8_SA
#undef PG8_SB
#undef PG8_STAGE
#undef PG8_LDA
#undef PG8_LDB
#undef PG8_MMA
#undef PG8_WAIT_V
#undef PG8_WAIT_L
#undef PG8_BAR
#undef PG8_SCHED
}
}

#ifndef PG8_SP2
#define PG8_SP2 true
#endif
#ifndef PG8_ALIGN
#define PG8_ALIGN true
#endif
#ifndef DUP_MASK
#define DUP_MASK 0
#endif
#ifndef DUP_REPS
#define DUP_REPS 2
#endif
#define DUPN(bit) (((DUP_MASK >> (bit)) & 1) ? DUP_REPS : 1)
#ifndef MK_N_LAUNCHES
#define MK_N_LAUNCHES 1
#endif

constexpr int NB = 4, SEQ = 4096, DM = 2048, MT = NB * SEQ;
constexpr int DNA = 1024, DHY = 1024, NHEAD = 16, DFF = 5632, NMODW = 6 * DM;
constexpr float EPS = 1e-6f;
constexpr int NWAVES = 8, NTHR = 512;
constexpr int N_PHASES = 10;

constexpr size_t MiB = 1u << 20;
constexpr size_t WS_CTL = 0, CTL_ZERO_BYTES = 1 * MiB;
constexpr size_t WS_MOD = 0;
constexpr size_t WS_SSQ1 = 256 * 1024;
constexpr size_t WS_BAR = 512 * 1024;
constexpr size_t WS_BIASU = 1 * MiB;
constexpr size_t WS_GMUL2 = 1 * MiB + 256 * 1024;
constexpr size_t WS_TW = 1 * MiB + 512 * 1024;
constexpr size_t WS_H3 = 2 * MiB;
constexpr size_t WS_WTIN = 4 * MiB;
constexpr size_t WS_WTOUT = 28 * MiB;
constexpr size_t WS_WTUP = 36 * MiB;
constexpr size_t WS_WTDN = 80 * MiB;
constexpr size_t WS_EDGEA = 102 * MiB;
constexpr size_t WS_EDGEB = 108 * MiB;
constexpr size_t WS_H1 = 112 * MiB;
constexpr size_t WS_QK = 176 * MiB;
constexpr size_t WS_VTHY = 240 * MiB;
constexpr size_t WS_GATED = 176 * MiB;
constexpr size_t WS_GT = 368 * MiB;
constexpr size_t WS_NAOUT = 400 * MiB;
constexpr size_t WS_HYOT = 432 * MiB;
constexpr size_t WS_A2 = 400 * MiB;
constexpr size_t WS_END = 464 * MiB;
static_assert(WS_GATED + (size_t)MT * DFF * 2 <= WS_GT && WS_EDGEB + 64ull * 2 * DFF * 4 <= WS_H1 && WS_EDGEA + 64ull * 4 * DFF * 4 <= WS_EDGEB, "ws map");

constexpr int RING_BYTES = 131072;
constexpr int XCH_OFF = RING_BYTES;
constexpr int LDS_BYTES = 163840;
constexpr int BARST_OFF = LDS_BYTES - 64;

#define GAS __attribute__((address_space(1)))
#define LAS __attribute__((address_space(3)))
typedef unsigned short bf16;
typedef unsigned v4u __attribute__((ext_vector_type(4)));
typedef unsigned v2u __attribute__((ext_vector_type(2)));
typedef float f32x4 __attribute__((ext_vector_type(4)));
typedef float f32x2 __attribute__((ext_vector_type(2)));
typedef float f32x16 __attribute__((ext_vector_type(16)));
typedef short bf16x8 __attribute__((ext_vector_type(8)));
typedef short s16x4 __attribute__((ext_vector_type(4)));

__device__ __forceinline__ unsigned f2bf(float f) { unsigned u = __builtin_bit_cast(unsigned, f); return (u + 0x7fffu + ((u >> 16) & 1u)) >> 16; }
__device__ __forceinline__ unsigned pk2(float lo, float hi) { typedef __bf16 bf2v_t __attribute__((ext_vector_type(2))); const f32x2 v = {lo, hi}; return __builtin_bit_cast(unsigned, __builtin_convertvector(v, bf2v_t)); }
__device__ __forceinline__ float bf2f(unsigned short h) { return __builtin_bit_cast(float, (unsigned)h << 16); }
__device__ __forceinline__ float bflo(unsigned w) { return __builtin_bit_cast(float, w << 16); }
__device__ __forceinline__ float bfhi(unsigned w) { return __builtin_bit_cast(float, w & 0xffff0000u); }
__device__ __forceinline__ float wave_sum(float v) {
#pragma unroll
    for (int o = 1; o < 64; o <<= 1) v += __shfl_xor(v, o);
    return v;
}

struct Frame {
    LAS unsigned char* lds;
    int tid, lane, wave, vcu, G;
    const float* const __attribute__((address_space(4)))* in;
    float* out; unsigned char* ws;
};

struct TItem { const float* W; bf16* WT; int K, N, mode, k0, n0; };
constexpr int P0_I_IN = (DM / 64) * (6144 / 32), P0_I_OUT = (DM / 64) * (DM / 32), P0_I_UP = (DM / 64) * (2 * DFF / 32), P0_I_DN = (DFF / 64) * (DM / 32);
constexpr int P0_NITEMS = P0_I_IN + P0_I_OUT + P0_I_UP + P0_I_DN;
__device__ __forceinline__ TItem p0_decode(Frame& F, int it) {
    TItem T; int r = it;
    if (r < P0_I_IN) { T.W = F.in[5]; T.WT = (bf16*)(F.ws + WS_WTIN); T.K = DM; T.N = 6144; T.mode = 0; }
    else if ((r -= P0_I_IN) < P0_I_OUT) { T.W = F.in[20]; T.WT = (bf16*)(F.ws + WS_WTOUT); T.K = DM; T.N = DM; T.mode = 1; }
    else if ((r -= P0_I_OUT) < P0_I_UP) { T.W = F.in[22]; T.WT = (bf16*)(F.ws + WS_WTUP); T.K = DM; T.N = 2 * DFF; T.mode = 2; }
    else { r -= P0_I_UP; T.W = F.in[25]; T.WT = (bf16*)(F.ws + WS_WTDN); T.K = DFF; T.N = DM; T.mode = 0; }
    const int nblk = T.N / 32; T.k0 = 64 * (r / nblk); T.n0 = 32 * (r % nblk);
    return T;
}
__device__ __forceinline__ void p0_load(const TItem& T, int lane, f32x4 (&v)[8]) {
#pragma unroll
    for (int i = 0; i < 8; ++i) v[i] = __builtin_nontemporal_load((const f32x4*)(T.W + (size_t)(T.k0 + 8 * i + (lane >> 3)) * T.N + T.n0 + 4 * (lane & 7)));
}
__device__ __forceinline__ void p0_store(const TItem& T, LAS float* scr, int lane, const f32x4 (&v)[8], const float* beta0, const float* beta1) {
#pragma unroll
    for (int i = 0; i < 8; ++i) { LAS float* d = scr + (8 * i + (lane >> 3)) * 33 + 4 * (lane & 7); d[0] = v[i][0]; d[1] = v[i][1]; d[2] = v[i][2]; d[3] = v[i][3]; }
    asm volatile("s_waitcnt lgkmcnt(0)" ::: "memory");
    const int c = lane & 7;
    float sc[8];
#pragma unroll
    for (int i = 0; i < 8; ++i) { sc[i] = 1.f; if (T.mode == 1) { const int k = T.k0 + 8 * c + i; sc[i] = k < 1024 ? beta0[k] : beta1[k - 1024]; } }
#pragma unroll
    for (int j = 0; j < 4; ++j) { const int n = (lane >> 3) + 8 * j; const LAS float* s = scr + (8 * c) * 33 + n;
        v4u o; o.x = pk2(s[0 * 33] * sc[0], s[1 * 33] * sc[1]); o.y = pk2(s[2 * 33] * sc[2], s[3 * 33] * sc[3]); o.z = pk2(s[4 * 33] * sc[4], s[5 * 33] * sc[5]); o.w = pk2(s[6 * 33] * sc[6], s[7 * 33] * sc[7]);
        int row = T.n0 + n;
        if (T.mode == 2) { const int isb = row >= DFF ? 1 : 0, j2 = row - isb * DFF; row = (j2 >> 7) * 256 + isb * 128 + (j2 & 127); }
        *(v4u*)(T.WT + (size_t)row * T.K + T.k0 + 8 * c) = o; }
    asm volatile("s_waitcnt lgkmcnt(0)" ::: "memory");
}
constexpr int P0_MLP_OFF = NWAVES * 64 * 33 * 4;
__device__ __forceinline__ void p0_mlp_pos(Frame& F, int p) {
    const LAS float* w1 = (const LAS float*)(F.lds + P0_MLP_OFF); const LAS float* b1 = w1 + 33 * 64; const LAS float* w2 = b1 + 64; const LAS float* b2 = w2 + 64 * 64;
    const LAS float* w3 = b2 + 64; const LAS float* b3 = w3 + 64 * 64; const LAS float* fq = b3 + 64;
    float* h3 = (float*)(F.ws + WS_H3);
    const float fql = fq[F.lane];
    const float tp = (float)p * (1.0f / 4095.0f), wp = (6.283185307179586f * (float)p) / 4096.0f;
    float z = 0.f;
    if (F.lane == 0) z = tp;
    else if (F.lane <= 16) { const float fr = 1e-4f + (float)(F.lane - 1) * ((15.0f - 1e-4f) / 15.0f); z = __cosf(fr * wp); }
    else if (F.lane <= 32) { const float fr = 1e-4f + (float)(F.lane - 17) * ((15.0f - 1e-4f) / 15.0f); z = -__sinf(fr * wp); }
    float acc = b1[F.lane];
#pragma unroll 11
    for (int i = 0; i < 33; ++i) acc += __builtin_bit_cast(float, __builtin_amdgcn_readlane(__builtin_bit_cast(int, z), i)) * w1[i * 64 + F.lane];
    float h = __sinf(fql * acc);
    acc = b2[F.lane];
#pragma unroll 8
    for (int i = 0; i < 64; ++i) acc += __builtin_bit_cast(float, __builtin_amdgcn_readlane(__builtin_bit_cast(int, h), i)) * w2[i * 64 + F.lane];
    h = __sinf(fql * acc);
    acc = b3[F.lane];
#pragma unroll 8
    for (int i = 0; i < 64; ++i) acc += __builtin_bit_cast(float, __builtin_amdgcn_readlane(__builtin_bit_cast(int, h), i)) * w3[i * 64 + F.lane];
    h = __sinf(fql * acc);
    h3[p * 64 + F.lane] = h;
}

__device__ __forceinline__ void p0_prologue(Frame& F) {
    const int gw = F.vcu * NWAVES + F.wave, NGW = F.G * NWAVES;
    {
        LAS float* m = (LAS float*)(F.lds + P0_MLP_OFF);
        for (int i = F.tid; i < 33 * 64; i += NTHR) m[i] = F.in[9][i];
        for (int i = F.tid; i < 64 * 64; i += NTHR) { m[33 * 64 + 64 + i] = F.in[11][i]; m[33 * 64 + 64 + 64 * 64 + 64 + i] = F.in[13][i]; }
        if (F.tid < 64) { m[33 * 64 + F.tid] = F.in[10][F.tid]; m[33 * 64 + 64 + 64 * 64 + F.tid] = F.in[12][F.tid]; m[33 * 64 + 64 + 64 * 64 + 64 + 64 * 64 + F.tid] = F.in[14][F.tid];
            m[33 * 64 + 64 + 64 * 64 + 64 + 64 * 64 + 64 + F.tid] = F.in[16][F.tid]; }
        __syncthreads();
    }
    {
        const float* cvec = F.in[1]; const float* wada = F.in[2]; const float* bada = F.in[3]; float* mod = (float*)(F.ws + WS_MOD);
        LAS float* red = (LAS float*)F.lds;
        auto mload = [&](int task, f32x4 (&w)[16]) { const int strip = task % 48, kbase = (task / 48) * 128 + F.wave * 16;
#pragma unroll
            for (int kk = 0; kk < 16; ++kk) w[kk] = __builtin_nontemporal_load((const f32x4*)(wada + (size_t)(kbase + kk) * NMODW + strip * 256 + F.lane * 4)); };
        auto mtask = [&](int task, const f32x4 (&w)[16]) { const int strip = task % 48, kc = task / 48, kbase = kc * 128 + F.wave * 16;
            f32x4 a0 = {0.f, 0.f, 0.f, 0.f}, a1 = a0, a2 = a0, a3 = a0;
#pragma unroll
            for (int kk = 0; kk < 16; ++kk) { const int k = kbase + kk;
                const float c0 = cvec[k], c1 = cvec[DM + k], c2 = cvec[2 * DM + k], c3 = cvec[3 * DM + k];
                a0 += w[kk] * (c0 / (1.f + __expf(-c0))); a1 += w[kk] * (c1 / (1.f + __expf(-c1))); a2 += w[kk] * (c2 / (1.f + __expf(-c2))); a3 += w[kk] * (c3 / (1.f + __expf(-c3))); }
            *(LAS f32x4*)(red + (F.wave * 4 + 0) * 256 + F.lane * 4) = a0; *(LAS f32x4*)(red + (F.wave * 4 + 1) * 256 + F.lane * 4) = a1;
            *(LAS f32x4*)(red + (F.wave * 4 + 2) * 256 + F.lane * 4) = a2; *(LAS f32x4*)(red + (F.wave * 4 + 3) * 256 + F.lane * 4) = a3;
            __syncthreads();
#pragma unroll
            for (int o2 = 0; o2 < 2; ++o2) { const int o = F.tid + 512 * o2, b = o >> 8, col = o & 255; float s = 0.f;
#pragma unroll
                for (int wv = 0; wv < 8; ++wv) s += red[(wv * 4 + b) * 256 + col];
                if (kc == 0) s += bada[strip * 256 + col];
                atomicAdd(mod + b * NMODW + strip * 256 + col, s); }
            __syncthreads(); };
        constexpr int NT = 48 * 16;
        int task = F.vcu; f32x4 wa[16], wb[16];
        if (task < NT) mload(task, wa);
        while (task < NT) {
            const int t2 = task + F.G; const bool h2 = t2 < NT;
            if (h2) mload(t2, wb);
            mtask(task, wa);
            if (!h2) break;
            const int t3 = t2 + F.G; const bool h3 = t3 < NT;
            if (h3) mload(t3, wa);
            mtask(t2, wb);
            if (!h3) break;
            task = t3;
        }
    }
    int mlp_p = gw;
    {
        LAS float* scr = (LAS float*)(F.lds + F.wave * (64 * 33 * 4));
        int it = gw; TItem Ta, Tb; f32x4 va[8], vb[8];
        if (it < P0_NITEMS) { Ta = p0_decode(F, it); p0_load(Ta, F.lane, va); }
        while (it < P0_NITEMS) {
            const int it2 = it + NGW; const bool h2 = it2 < P0_NITEMS;
            if (h2) { Tb = p0_decode(F, it2); p0_load(Tb, F.lane, vb); }
            if (mlp_p < SEQ) { p0_mlp_pos(F, mlp_p); mlp_p += NGW; }
            p0_store(Ta, scr, F.lane, va, F.in[18], F.in[19]);
            if (!h2) break;
            const int it3 = it2 + NGW; const bool h3 = it3 < P0_NITEMS;
            if (h3) { Ta = p0_decode(F, it3); p0_load(Ta, F.lane, va); }
            p0_store(Tb, scr, F.lane, vb, F.in[18], F.in[19]);
            if (!h3) break;
            it = it3;
        }
    }
    for (; mlp_p < SEQ; mlp_p += NGW) p0_mlp_pos(F, mlp_p);
    {
        f32x2* tw = (f32x2*)(F.ws + WS_TW);
        for (int k = F.vcu * NTHR + F.tid; k < 4096; k += F.G * NTHR) { float s, c; sincospif((float)k * (1.0f / 4096.0f), &s, &c); tw[k] = (f32x2){c, -s}; }
    }
}

__device__ __forceinline__ void p1_phase(Frame& F) {
    const int gw = F.vcu * NWAVES + F.wave, NGW = F.G * NWAVES;
    const float* mod = (const float*)(F.ws + WS_MOD);
    for (int rep = 0; rep < DUPN(12); ++rep) {
        const float* x = F.in[0]; const float* g = F.in[4]; bf16* h1 = (bf16*)(F.ws + WS_H1);
        for (int m0 = gw; m0 < MT; m0 += 2 * NGW) {
            f32x4 v[2][8];
#pragma unroll
            for (int r = 0; r < 2; ++r) { const f32x4* xr = (const f32x4*)(x + (size_t)(m0 + r * NGW) * DM) + F.lane;
#pragma unroll
                for (int j = 0; j < 8; ++j) v[r][j] = __builtin_nontemporal_load(xr + 64 * j); }
#pragma unroll
            for (int r = 0; r < 2; ++r) { const int m = m0 + r * NGW, b = m >> 12; float s = 0.f;
#pragma unroll
                for (int j = 0; j < 8; ++j) s += (v[r][j][0] * v[r][j][0] + v[r][j][1] * v[r][j][1]) + (v[r][j][2] * v[r][j][2] + v[r][j][3] * v[r][j][3]);
                const float rstd = 1.0f / sqrtf(wave_sum(s) * (1.0f / DM) + EPS);
                v2u* o = (v2u*)(h1 + (size_t)m * DM) + F.lane;
#pragma unroll
                for (int j = 0; j < 8; ++j) { const int k = 4 * F.lane + 256 * j;
                    const f32x4 gg = *(const f32x4*)(g + k), sh = *(const f32x4*)(mod + b * NMODW + k), sc = *(const f32x4*)(mod + b * NMODW + DM + k);
                    const f32x4 rr = v[r][j] * rstd * gg * (sc + 1.0f) + sh; v2u w; w.x = pk2(rr[0], rr[1]); w.y = pk2(rr[2], rr[3]); o[64 * j] = w; } }
        }
    }
    for (int rep = 0; rep < DUPN(13); ++rep) {
        const float* h3 = (const float*)(F.ws + WS_H3); const float* w4 = F.in[15]; float* Gt = (float*)(F.ws + WS_GT);
        LAS float* hT = (LAS float*)F.lds;
        LAS float* wl = (LAS float*)(F.lds + 64 * 132 * 4);
        const int tx = F.tid & 15, ty = F.tid >> 4;
        for (int task = F.vcu; task < 32 * 16; task += F.G) {
            const int p0 = (task & 31) * 128, c0 = (task >> 5) * 128;
            __syncthreads();
#pragma unroll
            for (int it = 0; it < 4; ++it) { const int idx = it * 512 + F.tid, pr = idx >> 4, k4 = (idx & 15) * 4;
                const f32x4 v = *(const f32x4*)(h3 + (size_t)(p0 + pr) * 64 + k4);
                hT[(k4 + 0) * 132 + pr] = v[0]; hT[(k4 + 1) * 132 + pr] = v[1]; hT[(k4 + 2) * 132 + pr] = v[2]; hT[(k4 + 3) * 132 + pr] = v[3]; }
#pragma unroll
            for (int it = 0; it < 4; ++it) { const int idx = it * 512 + F.tid, kr = idx >> 5, c4 = (idx & 31) * 4;
                *(LAS f32x4*)(wl + kr * 128 + c4) = *(const f32x4*)(w4 + (size_t)kr * 2048 + c0 + c4); }
            __syncthreads();
            f32x4 acc[4][2];
#pragma unroll
            for (int i = 0; i < 4; ++i) { acc[i][0] = (f32x4){0.f, 0.f, 0.f, 0.f}; acc[i][1] = (f32x4){0.f, 0.f, 0.f, 0.f}; }
#pragma unroll 8
            for (int k = 0; k < 64; ++k) { const f32x4 a = *(const LAS f32x4*)(hT + k * 132 + 4 * ty), b0 = *(const LAS f32x4*)(wl + k * 128 + 8 * tx), b1 = *(const LAS f32x4*)(wl + k * 128 + 8 * tx + 4);
#pragma unroll
                for (int i = 0; i < 4; ++i) { acc[i][0] += b0 * a[i]; acc[i][1] += b1 * a[i]; } }
            const int pb = p0 + 4 * ty;
            float tp[4];
#pragma unroll
            for (int i = 0; i < 4; ++i) tp[i] = (float)(pb + i) * (1.0f / 4095.0f);
#pragma unroll
            for (int cc = 0; cc < 8; ++cc) { const int col = c0 + 8 * tx + cc, c = col & 1023, bwd = col >> 10;
                const float dmin = -3.0701134573253945f, dmax = -15.350567286626972f;
                const float ad = fabsf(dmin + (float)c * ((dmax - dmin) / 1023.0f));
                f32x4 o;
#pragma unroll
                for (int i = 0; i < 4; ++i) o[i] = acc[i][cc >> 2][cc & 3] * __expf(-tp[i] * ad);
                *(f32x4*)(Gt + (size_t)c * 8192 + bwd * 4096 + pb) = o; }
        }
        __syncthreads();
    }
    for (int rep = 0; rep < DUPN(14); ++rep) {
        const bf16* wt = (const bf16*)(F.ws + WS_WTUP); float* bu = (float*)(F.ws + WS_BIASU);
        f32x4 sh[4][4][2];
#pragma unroll
        for (int b = 0; b < 4; ++b)
#pragma unroll
            for (int j = 0; j < 4; ++j) { const float* p = mod + b * NMODW + 3 * DM + 8 * F.lane + 512 * j; sh[b][j][0] = *(const f32x4*)p; sh[b][j][1] = *(const f32x4*)(p + 4); }
        for (int n = gw; n < 2 * DFF; n += NGW) {
            float sb[4] = {0.f, 0.f, 0.f, 0.f};
#pragma unroll
            for (int j = 0; j < 4; ++j) { const v4u w = *(const v4u*)(wt + (size_t)n * DM + 8 * F.lane + 512 * j);
                const f32x4 w0 = {bflo(w.x), bfhi(w.x), bflo(w.y), bfhi(w.y)}, w1 = {bflo(w.z), bfhi(w.z), bflo(w.w), bfhi(w.w)};
#pragma unroll
                for (int b = 0; b < 4; ++b) { const f32x4 t = w0 * sh[b][j][0] + w1 * sh[b][j][1]; sb[b] += (t[0] + t[1]) + (t[2] + t[3]); } }
#pragma unroll
            for (int b = 0; b < 4; ++b) sb[b] = wave_sum(sb[b]);
            if (F.lane == 0) { bu[n] = sb[0]; bu[2 * DFF + n] = sb[1]; bu[4 * DFF + n] = sb[2]; bu[6 * DFF + n] = sb[3]; }
        }
        float* gm = (float*)(F.ws + WS_GMUL2); const float* gf = F.in[21];
        for (int i = F.vcu * NTHR + F.tid; i < NB * DM; i += F.G * NTHR) { const int b = i >> 11, k = i & 2047; gm[i] = gf[k] * (1.0f + mod[b * NMODW + 4 * DM + k]); }
    }
}

typedef f32x2 cf;
__device__ __forceinline__ cf cmul(cf a, cf b) {
    cf t, r;
    asm("v_pk_mul_f32 %0, %2, %3 op_sel:[0,0] op_sel_hi:[0,1]\n\tv_pk_fma_f32 %1, %2, %3, %0 op_sel:[1,1,0] op_sel_hi:[1,0,1] neg_lo:[1,0,0]" : "=&v"(t), "=v"(r) : "v"(a), "v"(b));
    return r;
}
__device__ __forceinline__ cf cmulc(cf a, cf b) {
    cf t, r;
    asm("v_pk_mul_f32 %0, %2, %3 op_sel:[0,0] op_sel_hi:[0,1] neg_hi:[0,1]\n\tv_pk_fma_f32 %1, %2, %3, %0 op_sel:[1,1,0] op_sel_hi:[1,0,1]" : "=&v"(t), "=v"(r) : "v"(a), "v"(b));
    return r;
}
__device__ __forceinline__ cf cmul2(cf a, cf b, cf c) {
    cf t, r;
    asm("v_pk_mul_f32 %0, %2, %3 op_sel:[0,0] op_sel_hi:[0,1]\n\tv_pk_fma_f32 %1, %2, %3, %0 op_sel:[1,1,0] op_sel_hi:[1,0,1] neg_lo:[1,0,0]\n\t"
        "v_pk_mul_f32 %0, %1, %4 op_sel:[0,0] op_sel_hi:[0,1]\n\tv_pk_fma_f32 %1, %1, %4, %0 op_sel:[1,1,0] op_sel_hi:[1,0,1] neg_lo:[1,0,0]" : "=&v"(t), "=&v"(r) : "v"(a), "v"(b), "v"(c));
    return r;
}
__device__ __forceinline__ cf cmulc2(cf a, cf b, cf c) {
    cf t, r;
    asm("v_pk_mul_f32 %0, %2, %3 op_sel:[0,0] op_sel_hi:[0,1] neg_hi:[0,1]\n\tv_pk_fma_f32 %1, %2, %3, %0 op_sel:[1,1,0] op_sel_hi:[1,0,1]\n\t"
        "v_pk_mul_f32 %0, %1, %4 op_sel:[0,0] op_sel_hi:[0,1] neg_hi:[0,1]\n\tv_pk_fma_f32 %1, %1, %4, %0 op_sel:[1,1,0] op_sel_hi:[1,0,1]" : "=&v"(t), "=&v"(r) : "v"(a), "v"(b), "v"(c));
    return r;
}
template <bool CONJ> __device__ __forceinline__ cf mulc16(cf d, int J) {
    if (J == 0) return d;
    if (J == 4) return CONJ ? (cf){-d.y, d.x} : (cf){d.y, -d.x};
    const float C1 = 0.92387953251128674f, S1 = 0.38268343236508977f, R = 0.70710678118654752f;
    const int K = J & 3;
    const float cr = (K == 1) ? C1 : (K == 2) ? R : S1, ci = (K == 1) ? S1 : (K == 2) ? R : C1;
    cf w, r;
    if (!CONJ) { if (J < 4) { w = (cf){cr, -ci}; r = (cf){ci, cr}; } else { w = (cf){-ci, -cr}; r = (cf){cr, -ci}; } }
    else       { if (J < 4) { w = (cf){cr, ci}; r = (cf){-ci, cr}; } else { w = (cf){-ci, cr}; r = (cf){-cr, -ci}; } }
    return __builtin_elementwise_fma(__builtin_shufflevector(d, d, 1, 1), r, __builtin_shufflevector(d, d, 0, 0) * w);
}
struct Tw { cf w, r; };
__device__ __forceinline__ Tw tw_fwd(cf w) { Tw t; t.w = w; t.r = (cf){-w.y, w.x}; return t; }
__device__ __forceinline__ Tw tw_inv(cf w) { Tw t; t.w = (cf){w.x, -w.y}; t.r = (cf){w.y, w.x}; return t; }
__device__ __forceinline__ cf cmt(cf d, const Tw& t) { return __builtin_elementwise_fma(__builtin_shufflevector(d, d, 1, 1), t.r, __builtin_shufflevector(d, d, 0, 0) * t.w); }
__device__ __forceinline__ cf cmt_rot_fwd(cf d, const Tw& t) { return __builtin_elementwise_fma(__builtin_shufflevector(d, d, 1, 1), t.w, -(__builtin_shufflevector(d, d, 0, 0) * t.r)); }
__device__ __forceinline__ cf cmt_rot_inv(cf d, const Tw& t) { return __builtin_elementwise_fma(__builtin_shufflevector(d, d, 0, 0), t.r, -(__builtin_shufflevector(d, d, 1, 1) * t.w)); }
template <bool CONJ> __device__ __forceinline__ Tw c16tw(int J) {
    const float C1 = 0.92387953251128674f, S1 = 0.38268343236508977f, R = 0.70710678118654752f;
    const float cr = (J == 1) ? C1 : (J == 2) ? R : S1, ci = (J == 1) ? S1 : (J == 2) ? R : C1;
    Tw t; if (!CONJ) { t.w = (cf){cr, -ci}; t.r = (cf){ci, cr}; } else { t.w = (cf){cr, ci}; t.r = (cf){-ci, cr}; }
    return t;
}
template <bool CONJ> __device__ __forceinline__ cf mulc16w_s1(cf d, int J) { return (J & 3) ? cmt(d, c16tw<CONJ>(J & 3)) : d; }
template <bool CONJ> __device__ __forceinline__ cf mulc16w_s2(cf e, int J, const Tw& tw) { return (J < 4) ? cmt(e, tw) : (CONJ ? cmt_rot_inv(e, tw) : cmt_rot_fwd(e, tw)); }
template <bool TW> __device__ __forceinline__ void dif16(cf (&x)[16], cf w1) {
    Tw t1, t2, t4, t8;
    if (TW) { t1 = tw_fwd(w1); const cf w2 = cmt(w1, t1); t2 = tw_fwd(w2); const cf w4 = cmt(w2, t2); t4 = tw_fwd(w4); t8 = tw_fwd(cmt(w4, t4)); }
    cf d[8];
#pragma unroll
    for (int j = 0; j < 8; ++j) { const cf u = x[j], v = x[j + 8]; x[j] = u + v; d[j] = u - v; }
#pragma unroll
    for (int j = 0; j < 8; ++j) d[j] = TW ? mulc16w_s1<false>(d[j], j) : mulc16<false>(d[j], j);
#pragma unroll
    for (int j = 0; j < 8; ++j) x[j + 8] = TW ? mulc16w_s2<false>(d[j], j, t1) : d[j];
#pragma unroll
    for (int q = 0; q < 8; ++q) { const int j = (q & 3) + 8 * (q >> 2); const cf u = x[j], v = x[j + 4]; x[j] = u + v; d[q] = u - v; }
#pragma unroll
    for (int q = 0; q < 8; ++q) d[q] = TW ? mulc16w_s1<false>(d[q], 2 * (q & 3)) : mulc16<false>(d[q], 2 * (q & 3));
#pragma unroll
    for (int q = 0; q < 8; ++q) { const int j = (q & 3) + 8 * (q >> 2); x[j + 4] = TW ? mulc16w_s2<false>(d[q], 2 * (q & 3), t2) : d[q]; }
#pragma unroll
    for (int q = 0; q < 8; ++q) { const int j = (q & 1) + 4 * (q >> 1); const cf u = x[j], v = x[j + 2]; x[j] = u + v; d[q] = u - v; }
#pragma unroll
    for (int q = 0; q < 8; ++q) { const int j = (q & 1) + 4 * (q >> 1); x[j + 2] = TW ? mulc16w_s2<false>(d[q], 4 * (q & 1), t4) : mulc16<false>(d[q], 4 * (q & 1)); }
#pragma unroll
    for (int q = 0; q < 8; ++q) { const int j = 2 * q; const cf u = x[j], v = x[j + 1]; x[j] = u + v; d[q] = u - v; }
#pragma unroll
    for (int q = 0; q < 8; ++q) x[2 * q + 1] = TW ? cmt(d[q], t8) : d[q];
}
template <bool TW> __device__ __forceinline__ void dit16(cf (&x)[16], cf w1) {
    Tw t1, t2, t4, t8;
    if (TW) { const Tw f1 = tw_fwd(w1); const cf w2 = cmt(w1, f1); const Tw f2 = tw_fwd(w2); const cf w4 = cmt(w2, f2); const Tw f4 = tw_fwd(w4); const cf w8 = cmt(w4, f4);
        t1 = tw_inv(w1); t2 = tw_inv(w2); t4 = tw_inv(w4); t8 = tw_inv(w8); }
    cf v[8];
#pragma unroll
    for (int q = 0; q < 8; ++q) v[q] = TW ? cmt(x[2 * q + 1], t8) : x[2 * q + 1];
#pragma unroll
    for (int q = 0; q < 8; ++q) { const int j = 2 * q; const cf u = x[j]; x[j] = u + v[q]; x[j + 1] = u - v[q]; }
#pragma unroll
    for (int q = 0; q < 8; ++q) { const int j = (q & 1) + 4 * (q >> 1); v[q] = TW ? mulc16w_s2<true>(x[j + 2], 4 * (q & 1), t4) : mulc16<true>(x[j + 2], 4 * (q & 1)); }
#pragma unroll
    for (int q = 0; q < 8; ++q) { const int j = (q & 1) + 4 * (q >> 1); const cf u = x[j]; x[j] = u + v[q]; x[j + 2] = u - v[q]; }
#pragma unroll
    for (int q = 0; q < 8; ++q) { const int j = (q & 3) + 8 * (q >> 2); v[q] = TW ? mulc16w_s1<true>(x[j + 4], 2 * (q & 3)) : mulc16<true>(x[j + 4], 2 * (q & 3)); }
#pragma unroll
    for (int q = 0; q < 8; ++q) { if (TW) v[q] = mulc16w_s2<true>(v[q], 2 * (q & 3), t2); }
#pragma unroll
    for (int q = 0; q < 8; ++q) { const int j = (q & 3) + 8 * (q >> 2); const cf u = x[j]; x[j] = u + v[q]; x[j + 4] = u - v[q]; }
#pragma unroll
    for (int j = 0; j < 8; ++j) v[j] = TW ? mulc16w_s1<true>(x[j + 8], j) : mulc16<true>(x[j + 8], j);
#pragma unroll
    for (int j = 0; j < 8; ++j) { if (TW) v[j] = mulc16w_s2<true>(v[j], j, t1); }
#pragma unroll
    for (int j = 0; j < 8; ++j) { const cf u = x[j]; x[j] = u + v[j]; x[j + 8] = u - v[j]; }
}
constexpr int FFT_BUF_BYTES = 9216 * 8;
template <bool INV> __device__ __forceinline__ void fft_pass_a(LAS cf* buf, cf w1, int tid) {
    const int hi = tid >> 8, lo = tid & 255; LAS cf* p = buf + hi * 4608 + lo + 2 * (lo >> 4);
    cf x[16];
#pragma unroll
    for (int j = 0; j < 16; ++j) x[j] = p[288 * j];
    if (INV) dit16<true>(x, w1); else dif16<true>(x, w1);
#pragma unroll
    for (int j = 0; j < 16; ++j) p[288 * j] = x[j];
}
template <bool INV> __device__ __forceinline__ void fft_pass_b(LAS cf* buf, cf w1, int tid) {
    const int blk = tid >> 4, lo = tid & 15; LAS cf* p = buf + blk * 288 + lo;
    cf x[16];
#pragma unroll
    for (int j = 0; j < 16; ++j) x[j] = p[18 * j];
    if (INV) dit16<true>(x, w1); else dif16<true>(x, w1);
#pragma unroll
    for (int j = 0; j < 16; ++j) p[18 * j] = x[j];
}
__device__ __forceinline__ void fft_load_c(const LAS cf* buf, int tid, cf (&x)[16]) {
    const LAS f32x4* p = (const LAS f32x4*)(buf + 18 * tid);
#pragma unroll
    for (int j = 0; j < 8; ++j) { const f32x4 v = p[j]; x[2 * j] = (cf){v[0], v[1]}; x[2 * j + 1] = (cf){v[2], v[3]}; }
}
__device__ __forceinline__ void fft_store_c(LAS cf* buf, int tid, const cf (&x)[16]) {
    LAS f32x4* p = (LAS f32x4*)(buf + 18 * tid);
#pragma unroll
    for (int j = 0; j < 8; ++j) p[j] = (f32x4){x[2 * j].x, x[2 * j].y, x[2 * j + 1].x, x[2 * j + 1].y};
}
struct HyRaw { v4u w; unsigned hl, hr; };
__device__ __forceinline__ void hy_load_raw(HyRaw& R, const bf16* row, int t0) { R.w = __builtin_nontemporal_load((const v4u*)(row + t0)); R.hl = row[t0 > 0 ? t0 - 1 : 0]; R.hr = row[t0 + 8 < SEQ ? t0 + 8 : SEQ - 1]; }
__device__ __forceinline__ void hy_conv8(const HyRaw& R, int t0, const float (&cw)[4], float (&o)[8]) {
    const v4u w = R.w; float u[10];
    u[0] = t0 > 0 ? bf2f((unsigned short)R.hl) : 0.f; u[9] = t0 + 8 < SEQ ? bf2f((unsigned short)R.hr) : 0.f;
    u[1] = bflo(w.x); u[2] = bfhi(w.x); u[3] = bflo(w.y); u[4] = bfhi(w.y); u[5] = bflo(w.z); u[6] = bfhi(w.z); u[7] = bflo(w.w); u[8] = bfhi(w.w);
#pragma unroll
    for (int e = 0; e < 8; ++e) o[e] = cw[0] * u[e] + cw[1] * u[e + 1] + cw[2] * u[e + 2] + cw[3];
}
__device__ __forceinline__ cf mulsmall(cf w, int e) {
    float c, s;
    switch (e) { case 0: return w; case 1: c = 0.99999970586f; s = 0.00076699032f; break; case 2: c = 0.99999882345f; s = 0.00153398019f; break; case 3: c = 0.99999735277f; s = 0.00230096915f; break;
                 case 4: c = 0.99999529381f; s = 0.00306795676f; break; case 5: c = 0.99999264657f; s = 0.00383494256f; break; case 6: c = 0.99998941108f; s = 0.00460192612f; break; default: c = 0.99998558732f; s = 0.00536890696f; break; }
    Tw t; t.w = (cf){c, -s}; t.r = (cf){s, c};
    return cmt(w, t);
}
__device__ __forceinline__ void hyena_unit(Frame& F, int c) {
    LAS cf* buf0 = (LAS cf*)F.lds; LAS cf* buf1 = (LAS cf*)(F.lds + FFT_BUF_BYTES);
    const LAS cf* T1 = (const LAS cf*)(F.lds + 2 * FFT_BUF_BYTES); const LAS cf* T8 = T1 + 512;
    const int tid = F.tid, t0 = tid * 8;
    const float* Gt = (const float*)(F.ws + WS_GT) + (size_t)c * 8192;
    const bf16* hyT = (const bf16*)(F.ws + WS_VTHY); bf16* hyo = (bf16*)(F.ws + WS_HYOT);
    const float* sw = F.in[7]; const float* sb = F.in[8];
    const bf16* rx0 = hyT + (size_t)(1024 + c) * MT; const bf16* rx1 = hyT + (size_t)(2048 + c) * MT; const bf16* rv = hyT + (size_t)(3072 + c) * MT;
    HyRaw r1[4], r2[4];
#pragma unroll
    for (int b = 0; b < 4; ++b) { hy_load_raw(r1[b], rx1 + b * SEQ, t0); hy_load_raw(r2[b], rv + b * SEQ, t0); }
    const cf wa = T1[2 * (tid & 255)], wb = T8[4 * (tid & 15)];
#pragma unroll
    for (int e = 0; e < 8; ++e) { const int t = tid + 512 * e; const float g0 = __builtin_nontemporal_load(Gt + t), g1 = t ? __builtin_nontemporal_load(Gt + 8192 - t) : 0.f; const cf w = mulc16<false>(T1[tid], e); const float d = g0 - g1;
        LAS cf* p = buf0 + t + 2 * (t >> 4); p[0] = (cf){g0 + g1, 0.f}; p[4608] = (cf){d * w.x, d * w.y}; }
    __syncthreads();
    fft_pass_a<false>(buf0, wa, tid); __syncthreads();
    fft_pass_b<false>(buf0, wb, tid); __syncthreads();
    cf kf[16];
    fft_load_c(buf0, tid, kf); dif16<false>(kf, (cf){1.f, 0.f});
#pragma unroll
    for (int j = 0; j < 16; ++j) kf[j] = kf[j] * (1.0f / 8192.0f);
    __syncthreads();
    const float wx0[4] = {sw[c], sw[3072 + c], sw[6144 + c], sb[c]};
    const float wx1[4] = {sw[1024 + c], sw[3072 + 1024 + c], sw[6144 + 1024 + c], sb[1024 + c]};
    const float wv[4] = {sw[2048 + c], sw[3072 + 2048 + c], sw[6144 + 2048 + c], sb[2048 + c]};
    const float dbias = F.in[17][c];
    const int poff = t0 + 2 * (tid >> 1);
    float vv[4][8];
#pragma unroll
    for (int b = 0; b < 4; ++b) { float a[8], v[8]; hy_conv8(r1[b], t0, wx1, a); hy_conv8(r2[b], t0, wv, v);
#pragma unroll
        for (int e = 0; e < 8; ++e) vv[b][e] = a[e] * v[e]; }
#pragma unroll
    for (int e = 0; e < 8; ++e) { const Tw tw = tw_fwd(mulsmall(T8[tid], e)); const cf x0 = (cf){vv[0][e], vv[1][e]}, x1 = (cf){vv[2][e], vv[3][e]};
        buf0[poff + e] = x0; buf0[poff + 4608 + e] = cmt(x0, tw); buf1[poff + e] = x1; buf1[poff + 4608 + e] = cmt(x1, tw); }
    __syncthreads();
    fft_pass_a<false>(buf0, wa, tid); __builtin_amdgcn_sched_barrier(0); fft_pass_a<false>(buf1, wa, tid); __syncthreads();
    fft_pass_b<false>(buf0, wb, tid); __builtin_amdgcn_sched_barrier(0); fft_pass_b<false>(buf1, wb, tid); __syncthreads();
#pragma unroll
    for (int p = 0; p < 2; ++p) { LAS cf* buf = p ? buf1 : buf0; cf x[16]; fft_load_c(buf, tid, x); dif16<false>(x, (cf){1.f, 0.f});
#pragma unroll
        for (int j = 0; j < 16; ++j) x[j] = cmul(x[j], kf[j]);
        dit16<false>(x, (cf){1.f, 0.f}); fft_store_c(buf, tid, x); }
    __syncthreads();
    fft_pass_b<true>(buf0, wb, tid); __builtin_amdgcn_sched_barrier(0); fft_pass_b<true>(buf1, wb, tid); __syncthreads();
    HyRaw r0[4];
#pragma unroll
    for (int b = 0; b < 4; ++b) hy_load_raw(r0[b], rx0 + b * SEQ, t0);
    fft_pass_a<true>(buf0, wa, tid); __builtin_amdgcn_sched_barrier(0); fft_pass_a<true>(buf1, wa, tid); __syncthreads();
#pragma unroll
    for (int p = 0; p < 2; ++p) { const LAS cf* buf = p ? buf1 : buf0; cf y[8];
#pragma unroll
        for (int e = 0; e < 8; ++e) y[e] = buf[poff + e] + cmt(buf[poff + 4608 + e], tw_inv(mulsmall(T8[tid], e)));
#pragma unroll
        for (int bb = 0; bb < 2; ++bb) { const int b = 2 * p + bb; float x0[8], o[8];
            hy_conv8(r0[b], t0, wx0, x0);
#pragma unroll
            for (int e = 0; e < 8; ++e) o[e] = ((bb == 0 ? y[e].x : y[e].y) + vv[b][e] * dbias) * x0[e];
            v4u w; w.x = pk2(o[0], o[1]); w.y = pk2(o[2], o[3]); w.z = pk2(o[4], o[5]); w.w = pk2(o[6], o[7]);
            *(v4u*)(hyo + (size_t)c * MT + b * SEQ + t0) = w; } }
    __syncthreads();
}

#define NA_MFMA(a, b, c) __builtin_amdgcn_mfma_f32_32x32x16_bf16((a), (b), (c), 0, 0, 0)
__device__ __forceinline__ unsigned cvtpk(float lo, float hi) { typedef __bf16 bf2_t __attribute__((ext_vector_type(2))); const f32x2 v = {lo, hi}; const bf2_t b = __builtin_convertvector(v, bf2_t); return __builtin_bit_cast(unsigned, b); }
__device__ __forceinline__ void xhalf(float x, float& a, float& b) { const unsigned u = __builtin_bit_cast(unsigned, x); const auto r = __builtin_amdgcn_permlane32_swap(u, u, false, false); a = __builtin_bit_cast(float, (unsigned)r[0]); b = __builtin_bit_cast(float, (unsigned)r[1]); }
__device__ __forceinline__ void na_tile(const bf16x8 (&kf)[4], const bf16x8 (&vf)[2][2], const LAS unsigned char* qimg, f32x16 (&o)[2][2], float (&mrun)[2], float (&lrun)[2],
                                        const LAS float* brow, int kt, int hh8, const int (&cq)[2], const int (&cs)[2]) {
#pragma unroll
    for (int qt = 0; qt < 2; ++qt) {
        f32x16 s; bf16x8 qf[4];
#pragma unroll
        for (int e = 0; e < 16; ++e) s[e] = 0.f;
#pragma unroll
        for (int ds = 0; ds < 4; ++ds) qf[ds] = *(const LAS bf16x8*)(qimg + (qt * 4 + ds) * 1024);
        const int koff = 32 * kt + hh8;
        const LAS float* bp = brow + (koff - cq[qt] + 15);
        float bv[16];
#pragma unroll
        for (int e = 0; e < 16; ++e) bv[e] = bp[(e & 3) + 4 * ((e >> 2) & 1) + 16 * (e >> 3)];
        asm volatile("" ::: "memory");
#pragma unroll
        for (int ds = 0; ds < 4; ++ds) s = NA_MFMA(kf[ds], qf[ds], s);
        float mx = -INFINITY;
        const int vlo = koff - cs[qt];
#pragma unroll
        for (int e = 0; e < 16; ++e) { const bool valid = (unsigned)(vlo + ((e & 3) + 4 * ((e >> 2) & 1) + 16 * (e >> 3))) < 16u;
            const float v = valid ? s[e] + bv[e] : -INFINITY; s[e] = v; mx = fmaxf(mx, v); }
        { float a_, b_; xhalf(mx, a_, b_); mx = fmaxf(a_, b_); }
        if (__builtin_amdgcn_ballot_w64(mx > mrun[qt] + 8.0f) != 0ull) {
            const float mnew = fmaxf(mrun[qt], mx), ms = (mnew == -INFINITY) ? 0.f : mnew;
            const float alpha = __builtin_amdgcn_exp2f(mrun[qt] - ms);
            lrun[qt] *= alpha; mrun[qt] = mnew;
#pragma unroll
            for (int dt = 0; dt < 2; ++dt)
#pragma unroll
                for (int e = 0; e < 16; ++e) o[dt][qt][e] *= alpha;
        }
        const float msafe = (mrun[qt] == -INFINITY) ? 0.f : mrun[qt];
        float sum = 0.f;
#pragma unroll
        for (int e = 0; e < 16; ++e) { const float p = __builtin_amdgcn_exp2f(s[e] - msafe); s[e] = p; sum += p; }
        { float a_, b_; xhalf(sum, a_, b_); sum = a_ + b_; }
        lrun[qt] += sum;
        bf16x8 pf[2];
#pragma unroll
        for (int s2 = 0; s2 < 2; ++s2) { v4u p; p.x = cvtpk(s[8 * s2 + 0], s[8 * s2 + 1]); p.y = cvtpk(s[8 * s2 + 2], s[8 * s2 + 3]); p.z = cvtpk(s[8 * s2 + 4], s[8 * s2 + 5]); p.w = cvtpk(s[8 * s2 + 6], s[8 * s2 + 7]);
            pf[s2] = __builtin_bit_cast(bf16x8, p); }
#pragma unroll
        for (int dt = 0; dt < 2; ++dt)
#pragma unroll
            for (int s2 = 0; s2 < 2; ++s2) o[dt][qt] = NA_MFMA(vf[dt][s2], pf[s2], o[dt][qt]);
    }
}
__device__ __forceinline__ void na_load_k(bf16x8 (&kf)[4], const bf16* p) {
#pragma unroll
    for (int ds = 0; ds < 4; ++ds) kf[ds] = *(const bf16x8*)(p + 512 * ds);
}
__device__ __forceinline__ void na_load_v(bf16x8 (&vf)[2][2], const bf16* p) {
#pragma unroll
    for (int dt = 0; dt < 2; ++dt)
#pragma unroll
        for (int s2 = 0; s2 < 2; ++s2) vf[dt][s2] = *(const bf16x8*)(p + 512 * (dt * 2 + s2));
}
__device__ __forceinline__ void na_unit(Frame& F, int unit, LAS float* tab) {
    const int lane = F.lane, c32 = lane & 31, hh = lane >> 5;
    const int r = unit & 63, h = (unit >> 6) & 15, b = unit >> 10;
    const bf16* qkf = (const bf16*)(F.ws + WS_QK); const bf16* vfr = (const bf16*)(F.ws + WS_VTHY); bf16* nao = (bf16*)(F.ws + WS_NAOUT);
    const float* rpb = F.in[6] + h * 465;
    const int rs = min(max(r - 4, 0), 56);
    const size_t mq = (size_t)b * SEQ + r * 64;
    const bf16* qbase = qkf + (((size_t)(b * 16 + h) * 64 + r) * 8) * 512 + lane * 8;
    const bf16* kbase = qkf + (((size_t)((4 + b) * 16 + h) * 64 + rs) * 8) * 512 + lane * 8;
    const bf16* vbase = vfr + (((size_t)(b * 16 + h) * 64 + rs) * 8) * 512 + lane * 8;
    bf16x8 kfA[4], kfB[4], vf[2][2];
    na_load_k(kfA, kbase);
    for (int i = lane; i < 465; i += 64) tab[i] = rpb[i] * 1.4426950408889634f;
    LAS unsigned char* qimg = (LAS unsigned char*)tab + 2048 + lane * 16;
#pragma unroll
    for (int f = 0; f < 8; ++f) *(LAS v4u*)(qimg + f * 1024) = *(const v4u*)(qbase + 512 * f);
    f32x16 o[2][2];
#pragma unroll
    for (int dt = 0; dt < 2; ++dt)
#pragma unroll
        for (int qt = 0; qt < 2; ++qt)
#pragma unroll
            for (int e = 0; e < 16; ++e) o[dt][qt][e] = 0.f;
    float mrun[2] = {-INFINITY, -INFINITY}, lrun[2] = {0.f, 0.f};
    int cq[2], cs[2]; int hh8 = 8 * hh;
#pragma unroll
    for (int qt = 0; qt < 2; ++qt) { cq[qt] = 32 * qt + c32; cs[qt] = min(max(cq[qt] - 8, 0), 48); }
#pragma unroll 1
    for (int i = 0; i < 8; ++i) {
        const LAS float* brow = tab + (rs + i - r + 7) * 31;
        na_load_k(kfB, kbase + (size_t)(8 * i + 4) * 512);
        na_load_v(vf, vbase + (size_t)(8 * i) * 512);
        __builtin_amdgcn_sched_barrier(0);
        na_tile(kfA, vf, qimg, o, mrun, lrun, brow, 0, hh8, cq, cs);
        na_load_k(kfA, kbase + (size_t)(8 * (i < 7 ? i + 1 : i)) * 512);
        na_load_v(vf, vbase + (size_t)(8 * i + 4) * 512);
        __builtin_amdgcn_sched_barrier(0);
        na_tile(kfB, vf, qimg, o, mrun, lrun, brow, 1, hh8, cq, cs);
    }
    LAS unsigned char* oimg = (LAS unsigned char*)tab + 2048;
#pragma unroll
    for (int qt = 0; qt < 2; ++qt) { const float inv = 1.0f / lrun[qt]; const int q = 32 * qt + c32;
#pragma unroll
        for (int dt = 0; dt < 2; ++dt)
#pragma unroll
            for (int g = 0; g < 4; ++g) { v2u w; w.x = cvtpk(o[dt][qt][4 * g] * inv, o[dt][qt][4 * g + 1] * inv); w.y = cvtpk(o[dt][qt][4 * g + 2] * inv, o[dt][qt][4 * g + 3] * inv);
                const int d = 32 * dt + 8 * g + 4 * hh;
                *(LAS v2u*)(oimg + q * 128 + ((((d >> 3) ^ (q & 7)) << 4) | ((d & 4) << 1))) = w; } }
    asm volatile("s_waitcnt lgkmcnt(0)" ::: "memory");
#pragma unroll
    for (int it = 0; it < 8; ++it) { const int q = it * 8 + (lane >> 3), ch = lane & 7;
        const v4u w = *(const LAS v4u*)(oimg + q * 128 + ((ch ^ (q & 7)) << 4));
        *(v4u*)(nao + (mq + q) * DNA + h * 64 + 8 * ch) = w; }
    asm volatile("s_waitcnt lgkmcnt(0)" ::: "memory");
}

__device__ __forceinline__ void p3_phase(Frame& F) {
    {
        const f32x2* twg = (const f32x2*)(F.ws + WS_TW); LAS f32x2* T1 = (LAS f32x2*)(F.lds + 2 * FFT_BUF_BYTES);
        T1[F.tid] = twg[F.tid]; T1[512 + F.tid] = twg[8 * F.tid];
        __syncthreads();
    }
#ifndef NO_HYENA
    for (int rep = 0; rep < DUPN(10); ++rep)
    for (int c = F.vcu; c < DHY; c += F.G) hyena_unit(F, c);
#endif
#ifndef NO_NA
    LAS float* tab = (LAS float*)(F.lds + F.wave * 10240);
    __syncthreads();
    for (int rep = 0; rep < DUPN(11); ++rep)
    for (int u8 = F.vcu; u8 < (NB * NHEAD * 64) / 8; u8 += F.G) na_unit(F, u8 * 8 + F.wave, tab);
#endif
}

__device__ __forceinline__ void p4_phase(Frame& F) {
    constexpr int PITCH = 1032;
    LAS bf16* tile = (LAS bf16*)F.lds;
    const bf16* hyo = (const bf16*)(F.ws + WS_HYOT); const bf16* nao = (const bf16*)(F.ws + WS_NAOUT); bf16* mg = (bf16*)(F.ws + WS_H1);
    for (int tb = F.vcu; tb < MT / 64; tb += F.G) {
        const int m0 = tb * 64;
#pragma unroll 4
        for (int it = 0; it < 16; ++it) { const int c = it * 64 + (F.tid >> 3), ch = F.tid & 7;
            const v4u w = __builtin_nontemporal_load((const v4u*)(hyo + (size_t)c * MT + m0 + ch * 8));
            LAS bf16* d = tile + (ch * 8) * PITCH + (c ^ (ch << 4));
            d[0] = (bf16)(w.x & 0xffff); d[PITCH] = (bf16)(w.x >> 16); d[2 * PITCH] = (bf16)(w.y & 0xffff); d[3 * PITCH] = (bf16)(w.y >> 16);
            d[4 * PITCH] = (bf16)(w.z & 0xffff); d[5 * PITCH] = (bf16)(w.z >> 16); d[6 * PITCH] = (bf16)(w.w & 0xffff); d[7 * PITCH] = (bf16)(w.w >> 16); }
        __syncthreads();
        for (int tk = F.wave * 8; tk < F.wave * 8 + 8; ++tk) {
            const size_t m = (size_t)m0 + tk;
            {
                const int gsw = (F.lane ^ (tk >> 3)) * 16;
                const v4u w0 = *(const LAS v4u*)(tile + tk * PITCH + gsw), w1 = *(const LAS v4u*)(tile + tk * PITCH + gsw + 8);
                const unsigned ww[8] = {w0.x, w0.y, w0.z, w0.w, w1.x, w1.y, w1.z, w1.w}; float f[16]; float s = 0.f;
#pragma unroll
                for (int e = 0; e < 8; ++e) { f[2 * e] = bflo(ww[e]); f[2 * e + 1] = bfhi(ww[e]); s += f[2 * e] * f[2 * e] + f[2 * e + 1] * f[2 * e + 1]; }
                const float rstd = 1.0f / sqrtf(wave_sum(s) * (1.0f / DHY) + EPS);
                v4u o0, o1; o0.x = pk2(f[0] * rstd, f[1] * rstd); o0.y = pk2(f[2] * rstd, f[3] * rstd); o0.z = pk2(f[4] * rstd, f[5] * rstd); o0.w = pk2(f[6] * rstd, f[7] * rstd);
                o1.x = pk2(f[8] * rstd, f[9] * rstd); o1.y = pk2(f[10] * rstd, f[11] * rstd); o1.z = pk2(f[12] * rstd, f[13] * rstd); o1.w = pk2(f[14] * rstd, f[15] * rstd);
                v4u* dst = (v4u*)(mg + m * DM + DNA + F.lane * 16); dst[0] = o0; dst[1] = o1;
            }
            {
                const v4u* src = (const v4u*)(nao + m * DNA + F.lane * 16); const v4u w0 = __builtin_nontemporal_load(src), w1 = __builtin_nontemporal_load(src + 1);
                const unsigned ww[8] = {w0.x, w0.y, w0.z, w0.w, w1.x, w1.y, w1.z, w1.w}; float f[16]; float s = 0.f;
#pragma unroll
                for (int e = 0; e < 8; ++e) { f[2 * e] = bflo(ww[e]); f[2 * e + 1] = bfhi(ww[e]); s += f[2 * e] * f[2 * e] + f[2 * e + 1] * f[2 * e + 1]; }
                const float rstd = 1.0f / sqrtf(wave_sum(s) * (1.0f / DNA) + EPS);
                v4u o0, o1; o0.x = pk2(f[0] * rstd, f[1] * rstd); o0.y = pk2(f[2] * rstd, f[3] * rstd); o0.z = pk2(f[4] * rstd, f[5] * rstd); o0.w = pk2(f[6] * rstd, f[7] * rstd);
                o1.x = pk2(f[8] * rstd, f[9] * rstd); o1.y = pk2(f[10] * rstd, f[11] * rstd); o1.z = pk2(f[12] * rstd, f[13] * rstd); o1.w = pk2(f[14] * rstd, f[15] * rstd);
                v4u* dst = (v4u*)(mg + m * DM + F.lane * 16); dst[0] = o0; dst[1] = o1;
            }
        }
        __syncthreads();
    }
}

__device__ __forceinline__ void p_fixup_panel(Frame& F, int pm) {
    const float* eA = (const float*)(F.ws + WS_EDGEA); const float* eB = (const float*)(F.ws + WS_EDGEB); bf16* gated = (bf16*)(F.ws + WS_GATED);
    const float* cw = F.in[23]; const float* cb = F.in[24];
    for (int i = F.tid; i < 2 * DFF; i += NTHR) {
        const int bot = i >= DFF ? 1 : 0, j = i - bot * DFF;
        if (!bot && (pm & 15) == 0) continue;
        if (bot && (pm & 15) == 15) continue;
        float pv, cv, nv, bv; int row;
        if (!bot) { pv = eA[((size_t)(pm - 1) * 4 + 3) * DFF + j]; cv = eA[((size_t)pm * 4 + 0) * DFF + j]; nv = eA[((size_t)pm * 4 + 1) * DFF + j]; bv = eB[((size_t)pm * 2 + 0) * DFF + j]; row = pm * 256; }
        else { pv = eA[((size_t)pm * 4 + 2) * DFF + j]; cv = eA[((size_t)pm * 4 + 3) * DFF + j]; nv = eA[((size_t)(pm + 1) * 4 + 0) * DFF + j]; bv = eB[((size_t)pm * 2 + 1) * DFF + j]; row = pm * 256 + 255; }
        const float a = cw[j] * pv + cw[DFF + j] * cv + cw[2 * DFF + j] * nv + cb[j];
        const float g = 0.5f * a * (1.0f + erff(a * 0.70710678118654752f));
        gated[(size_t)row * DFF + j] = (bf16)f2bf(g * bv);
    }
}
__device__ __forceinline__ void p_final(Frame& F) {
    const int gw = F.vcu * NWAVES + F.wave, NGW = F.G * NWAVES; const float* g = F.in[26]; const bf16* x2 = (const bf16*)(F.ws + WS_H1);
    for (int m = gw; m < MT; m += NGW) {
        const v4u* xr = (const v4u*)(x2 + (size_t)m * DM) + F.lane; f32x4* orow = (f32x4*)(F.out + (size_t)m * DM); v4u w[4]; float s = 0.f;
#pragma unroll
        for (int j = 0; j < 4; ++j) w[j] = __builtin_nontemporal_load(xr + 64 * j);
        float f[4][8];
#pragma unroll
        for (int j = 0; j < 4; ++j) { f[j][0] = bflo(w[j].x); f[j][1] = bfhi(w[j].x); f[j][2] = bflo(w[j].y); f[j][3] = bfhi(w[j].y); f[j][4] = bflo(w[j].z); f[j][5] = bfhi(w[j].z); f[j][6] = bflo(w[j].w); f[j][7] = bfhi(w[j].w);
#pragma unroll
            for (int e = 0; e < 8; ++e) s += f[j][e] * f[j][e]; }
        const float rstd = 1.0f / sqrtf(wave_sum(s) * (1.0f / DM) + EPS);
#pragma unroll
        for (int j = 0; j < 4; ++j) { const int k = 8 * F.lane + 512 * j; const f32x4 g0 = *(const f32x4*)(g + k), g1 = *(const f32x4*)(g + k + 4);
            __builtin_nontemporal_store((f32x4){f[j][0], f[j][1], f[j][2], f[j][3]} * rstd * g0, orow + (k >> 2)); __builtin_nontemporal_store((f32x4){f[j][4], f[j][5], f[j][6], f[j][7]} * rstd * g1, orow + (k >> 2) + 1); }
    }
}

#define XB_TMO      128
#define XB_XCNT(j)  (256  + 64 * (j))
#define XB_XSUB(j)  (1280 + 64 * (j))
#define XB_XGEN(j)  (2304 + 64 * (j))
#define XB_TOP      3328
#define XB_TOPGEN   3392
#define XCD_BAR_WORDS 3456
#define XB_SPIN_CAP (1u << 18)

__device__ __forceinline__ unsigned xb_ld(unsigned* p)              { return __hip_atomic_load(p, __ATOMIC_RELAXED, __HIP_MEMORY_SCOPE_AGENT); }
__device__ __forceinline__ unsigned xb_add(unsigned* p, unsigned v) { return __hip_atomic_fetch_add(p, v, __ATOMIC_RELAXED, __HIP_MEMORY_SCOPE_AGENT); }
__device__ __forceinline__ unsigned xb_xcc_id() { return (unsigned)__builtin_amdgcn_s_getreg((3 << 11) | 20) & 0xFu; }
#define XB_SPIN(cond, bar) do { unsigned _sp = 0; while (cond) { __builtin_amdgcn_s_sleep(1); \
    if ((++_sp & 255u) == 0u) { if (xb_ld(&(bar)[XB_TMO])) break; if (_sp > XB_SPIN_CAP) { atomicAdd(&(bar)[XB_TMO], 1u); break; } } } } while (0)

struct XcdBarrier {
    unsigned* bar; unsigned x;
    volatile LAS unsigned* st;
};

__device__ __forceinline__ XcdBarrier xcd_barrier_post(unsigned* bar, volatile LAS unsigned* st) {
    XcdBarrier b; b.bar = bar; b.x = xb_xcc_id(); b.st = st;
    if (threadIdx.x == 0) (void)xb_add(&bar[XB_XCNT(b.x)], 1u);
    return b;
}
__device__ __forceinline__ void xcd_barrier_complete(unsigned* bar, unsigned x, unsigned& nloc, unsigned& nx) {
    const unsigned G = gridDim.x * gridDim.y * gridDim.z;
    unsigned sum, cnt, mine, sp = 0u;
    for (;;) {
        sum = 0u; cnt = 0u; mine = 0u;
#pragma unroll
        for (unsigned j = 0; j < 16; ++j) { const unsigned c = xb_ld(&bar[XB_XCNT(j)]); sum += c; cnt += (c > 0u) ? 1u : 0u; mine = (j == x) ? c : mine; }
        if (sum == G) break;
        __builtin_amdgcn_s_sleep(1);
        if ((++sp & 255u) == 0u) { if (xb_ld(&bar[XB_TMO])) break; if (sp > XB_SPIN_CAP) { atomicAdd(&bar[XB_TMO], 1u); break; } }
    }
    nloc = mine > 0u ? mine : 1u; nx = cnt > 0u ? cnt : 1u;
}

__device__ __forceinline__ void xcd_barrier(const XcdBarrier& b) {
    asm volatile("s_waitcnt vmcnt(0)" ::: "memory");
    __syncthreads();
    if (threadIdx.x == 0) {
        unsigned* bar = b.bar;
        __builtin_amdgcn_s_waitcnt(0);
        unsigned nloc = b.st[0], nx = b.st[1];
        if (nloc == 0u) { xcd_barrier_complete(bar, b.x, nloc, nx); b.st[0] = nloc; b.st[1] = nx; }
        const unsigned old = xb_add(&bar[XB_XSUB(b.x)], 1u);
        const unsigned gen = old / nloc;
        if (old + 1u == (gen + 1u) * nloc) {
            __builtin_amdgcn_fence(__ATOMIC_RELEASE, "agent");
            asm volatile("s_waitcnt vmcnt(0)" ::: "memory");
            const unsigned og = xb_add(&bar[XB_TOP], 1u);
            const unsigned tg = og / nx;
            if (og + 1u == (tg + 1u) * nx) xb_add(&bar[XB_TOPGEN], 1u);
            else XB_SPIN(xb_ld(&bar[XB_TOPGEN]) == tg, bar);
            __builtin_amdgcn_fence(__ATOMIC_ACQUIRE, "agent");
            xb_add(&bar[XB_XGEN(b.x)], 1u);
            asm volatile("s_waitcnt vmcnt(0)" ::: "memory");
        } else {
            XB_SPIN(xb_ld(&bar[XB_XGEN(b.x)]) == gen, bar);
            __builtin_amdgcn_fence(__ATOMIC_ACQUIRE, "agent");
            asm volatile("s_waitcnt vmcnt(0)" ::: "memory");
        }
    }
    __syncthreads();
}


struct Args { const float* in[27]; float* out; unsigned char* ws; int ph_lo, ph_hi; };
__global__ void __launch_bounds__(NTHR, 2) fwd_megakernel(Args args) {
    extern __shared__ __attribute__((aligned(16))) unsigned char lds[];
    cg::grid_group grid = cg::this_grid();
    Frame F;
    F.lds = (LAS unsigned char*)lds;
    F.tid = threadIdx.x; F.lane = F.tid & 63; F.wave = __builtin_amdgcn_readfirstlane(F.tid >> 6);
    F.G = gridDim.x; { const int bx = blockIdx.x; F.vcu = (F.G % 8 == 0) ? (bx % 8) * (F.G / 8) + bx / 8 : bx; }
    F.in = (const float* const __attribute__((address_space(4)))*)__builtin_amdgcn_kernarg_segment_ptr();
    F.out = args.out; F.ws = args.ws;
    const int lo = args.ph_lo, hi = args.ph_hi;
#ifndef PHASE_MASK
#define PHASE_MASK 0x3ff
#endif
#define IN(k) (((PHASE_MASK >> (k)) & 1) && lo <= (k) && (k) < hi)
    const bool one_launch = (lo == 0 && hi == N_PHASES);
    volatile LAS unsigned* barst = (volatile LAS unsigned*)(F.lds + BARST_OFF);
    if (F.tid < 2) barst[F.tid] = 0u;
    __syncthreads();
    XcdBarrier bar; bar.bar = (unsigned*)(args.ws + WS_BAR); bar.x = 0; bar.st = barst;
    if (one_launch) bar = xcd_barrier_post((unsigned*)(args.ws + WS_BAR), barst);
#define SEAM(k) do { if (IN(k) && IN((k) + 1)) { if (!one_launch) grid.sync(); else xcd_barrier(bar); } } while (0)
    unsigned char* ws = args.ws;
    if (IN(0)) { p0_prologue(F); } SEAM(0);
    if (IN(1)) { for (int rep = 0; rep < DUPN(1); ++rep) p1_phase(F); } SEAM(1);
    if (IN(2)) for (int rep = 0; rep < DUPN(2); ++rep) {
        {
            pg8::Gemm g{(const pg8::bf16_t*)(ws + WS_H1), (const pg8::bf16_t*)(ws + WS_WTIN), MT, 2048, DM}; pg8::StaticOrder S; S.init(MT, 2048, F.G, (int)blockIdx.x);
            pg8::EpiFragQK E{(pg8::bf16_t*)(ws + WS_QK), 0.125f * 1.4426950408889634f};
            pg8::gemm_phase<pg8::EpiFragQK, pg8::StaticOrder, PG8_ALIGN, PG8_SP2>(F.lds, g, S, E);
        }
        {
            pg8::Gemm g{(const pg8::bf16_t*)(ws + WS_WTIN) + (size_t)2048 * DM, (const pg8::bf16_t*)(ws + WS_H1), 4096, MT, DM}; pg8::StaticOrder S; S.init(4096, MT, F.G, (int)blockIdx.x);
            pg8::EpiVHy E{(pg8::bf16_t*)(ws + WS_VTHY), MT};
            pg8::gemm_phase<pg8::EpiVHy, pg8::StaticOrder, PG8_ALIGN, PG8_SP2>(F.lds, g, S, E);
        }
    } SEAM(2);
    if (IN(3)) { p3_phase(F); } SEAM(3);
    if (IN(4)) { for (int rep = 0; rep < DUPN(4); ++rep) p4_phase(F); } SEAM(4);
    if (IN(5)) {
        const float* mod = (const float*)(ws + WS_MOD);
        pg8::Gemm g{(const pg8::bf16_t*)(ws + WS_H1), (const pg8::bf16_t*)(ws + WS_WTOUT), MT, DM, DM}; pg8::StaticOrder S; S.init(MT, DM, F.G, (int)blockIdx.x);
        pg8::EpiRes1 E{F.in[0], (pg8::bf16_t*)F.out, (pg8::bf16_t*)(ws + WS_A2), mod + 2 * DM, NMODW, (const float*)(ws + WS_GMUL2), (float*)(ws + WS_SSQ1), DM};
        pg8::gemm_phase<pg8::EpiRes1, pg8::StaticOrder, PG8_ALIGN, PG8_SP2>(F.lds, g, S, E);
    } SEAM(5);
    if (IN(6)) for (int rep = 0; rep < DUPN(6); ++rep) {
        pg8::Gemm g{(const pg8::bf16_t*)(ws + WS_A2), (const pg8::bf16_t*)(ws + WS_WTUP), MT, 2 * DFF, DM}; pg8::StaticOrder S; S.init(MT, 2 * DFF, F.G, (int)blockIdx.x);
        pg8::EpiGlu E{(pg8::bf16_t*)(ws + WS_GATED), (const float*)(ws + WS_SSQ1), (const float*)(ws + WS_BIASU), F.in[23], F.in[24], (float*)(ws + WS_EDGEA), (float*)(ws + WS_EDGEB), (PG8_LAS float*)(F.lds + XCH_OFF), DFF};
        pg8::gemm_phase<pg8::EpiGlu, pg8::StaticOrder, true, PG8_SP2>(F.lds, g, S, E);
    } SEAM(6);
    if (IN(8)) {
        const float* mod = (const float*)(ws + WS_MOD);
        pg8::Gemm g{(const pg8::bf16_t*)(ws + WS_GATED), (const pg8::bf16_t*)(ws + WS_WTDN), MT, DM, DFF}; pg8::StaticOrder S; S.init(MT, DM, F.G, (int)blockIdx.x);
        { pg8::Unit u; for (int i = 0; S.next(i, u); ++i) p_fixup_panel(F, u.pm); asm volatile("s_waitcnt vmcnt(0)" ::: "memory"); __syncthreads(); }
        pg8::EpiRes2 E{(const pg8::bf16_t*)F.out, (pg8::bf16_t*)(ws + WS_H1), mod + 5 * DM, NMODW, DM};
        pg8::gemm_phase<pg8::EpiRes2, pg8::StaticOrder, PG8_ALIGN, PG8_SP2>(F.lds, g, S, E);
    } SEAM(8);
    if (IN(9)) { p_final(F); }
#undef IN
#undef SEAM
}

extern "C" void kernel_launch(void* const* d_in, const int* in_sizes, int n_in, void* d_out, int out_size, void* d_ws, size_t ws_size, hipStream_t stream) {
    static int grid = 0;
    if (grid == 0) {
        if (n_in != 27 || out_size != MT * DM || ws_size < WS_END) { fprintf(stderr, "kernel_launch: unexpected sizes n_in %d out %d ws %zu\n", n_in, out_size, ws_size); grid = -1; return; }
        int dev = 0, cus = 0, per_cu = 0;
        if (hipGetDevice(&dev) != hipSuccess || hipDeviceGetAttribute(&cus, hipDeviceAttributeMultiprocessorCount, dev) != hipSuccess) { grid = -1; return; }
        if (hipFuncSetAttribute((const void*)fwd_megakernel, hipFuncAttributeMaxDynamicSharedMemorySize, LDS_BYTES) != hipSuccess) { fprintf(stderr, "kernel_launch: hipFuncSetAttribute failed\n"); grid = -1; return; }
        if (hipOccupancyMaxActiveBlocksPerMultiprocessor(&per_cu, (const void*)fwd_megakernel, NTHR, LDS_BYTES) != hipSuccess || per_cu < 1) { fprintf(stderr, "kernel_launch: occupancy query says %d\n", per_cu); grid = -1; return; }
        grid = cus;
    }
    if (grid < 0) return;
    (void)hipMemsetAsync((char*)d_ws + WS_CTL, 0, CTL_ZERO_BYTES, stream);
    Args a{};
    for (int i = 0; i < 27; ++i) a.in[i] = (const float*)d_in[i];
    a.out = (float*)d_out; a.ws = (unsigned char*)d_ws;
    constexpr int NL = MK_N_LAUNCHES;
#ifndef DUP_LAUNCH
#define DUP_LAUNCH -1
#endif
    for (int li = 0; li < NL; ++li)
    for (int rep = 0; rep < ((NL > 1 && li == DUP_LAUNCH) ? 2 : 1); ++rep) {
        if (rep == 1 && li == 0) (void)hipMemsetAsync((char*)d_ws + WS_CTL, 0, CTL_ZERO_BYTES, stream);
        if (rep == 1 && li == 5) (void)hipMemsetAsync((char*)d_ws + WS_SSQ1, 0, MT * 4, stream);
        a.ph_lo = (NL == 1) ? 0 : li; a.ph_hi = (NL == 1) ? N_PHASES : li + 1;
        void* kargs[] = {&a};
        const hipError_t e = hipLaunchCooperativeKernel((const void*)fwd_megakernel, dim3(grid), dim3(NTHR), kargs, LDS_BYTES, stream);
        if (e != hipSuccess) { fprintf(stderr, "kernel_launch: cooperative launch failed: %s\n", hipGetErrorString(e)); break; }
    }
}
```

```cpp
#include <hip/hip_runtime.h>
#include <hip/hip_cooperative_groups.h>
#include <cstdio>
#include <cstdint>
namespace cg = cooperative_groups;
namespace pg8 {
#define PG8_LAS __attribute__((address_space(3)))
typedef unsigned short bf16_t;
typedef short bf16x8 __attribute__((ext_vector_type(8)));
typedef float f32x4 __attribute__((ext_vector_type(4)));
typedef unsigned u32x4 __attribute__((ext_vector_type(4)));
constexpr int BM = 256, BK = 64, HALF = 128, HTB = HALF * BK * 2  , STAGE_BYTES = 8 * HTB, NXCD = 8, WGM = 8;

__host__ __device__ __forceinline__ int lds_byte(int r, int c) { const int st = (r >> 4) * 2 + (c >> 5), rr = r & 15, cc = c & 31, ob = rr * 64 + cc * 2; return st * 1024 + (ob ^ (((ob >> 9) & 1) << 5)); }
__host__ __device__ __forceinline__ void stage_rc(int b, int& R, int& C) { const int st = b / 1024, sb = b % 1024, swz = sb ^ (((sb >> 9) & 1) << 5); R = (st >> 1) * 16 + swz / 64; C = (st & 1) * 32 + (swz % 64) / 2; }
__host__ __device__ __forceinline__ int perm32(int rho) { const int n = rho >> 4, i = rho & 15; return 8 * (i >> 2) + 4 * n + (i & 3); }

struct Unit { int pm, pn; };
struct Gemm { const bf16_t* A; const bf16_t* Bt; int M, N, K; };

struct StaticOrder {
    int nM, nN, nwg, G, c;
    __host__ __device__ void init(int M, int N, int G_, int c_) { nM = M / BM; nN = N / BM; nwg = nM * nN; G = G_; c = c_; }
    __host__ __device__ bool next(int i, Unit& u) const {
        const long L = (long)i * G + c; if (L >= nwg) return false;
        int wgid = (int)L; { const int q = nwg / NXCD, r = nwg % NXCD, xcd = wgid % NXCD, off = wgid / NXCD; wgid = (xcd < r ? xcd * (q + 1) : r * (q + 1) + (xcd - r) * q) + off; }
        const int nig = WGM * nN, gid = wgid / nig, fm = gid * WGM, gsz = (nM - fm) < WGM ? (nM - fm) : WGM;
        u.pm = fm + ((wgid % nig) % gsz); u.pn = (wgid % nig) / gsz; return true;
    }
    __device__ __forceinline__ void a_ready(const Unit&) const {}
    __device__ __forceinline__ void done(const Unit&) const {}
};

__device__ __forceinline__ unsigned cvt_pk_bf16(float lo, float hi) { unsigned r; asm volatile("v_cvt_pk_bf16_f32 %0, %1, %2" : "=v"(r) : "v"(lo), "v"(hi)); return r; }
typedef float f32x2 __attribute__((ext_vector_type(2)));
__device__ __forceinline__ f32x2 gelu_pk(f32x2 v) {
    const f32x2 av = __builtin_elementwise_abs(v), d = av * 0.2316418882f + 1.0f;
    f32x2 t; t.x = __builtin_amdgcn_rcpf(d.x); t.y = __builtin_amdgcn_rcpf(d.y);
    f32x2 q = t * 0.5307027145f + (-0.7265760135f); q = q * t + 0.7107068705f; q = q * t + (-0.142248368f); q = q * t + 0.127414796f; q = q * t;
    const f32x2 s = (v * v) * (-0.72134752044f);
    f32x2 e; e.x = __builtin_amdgcn_exp2f(s.x); e.y = __builtin_amdgcn_exp2f(s.y);
    const f32x2 m = v * (q * e), r = v - m;
    f32x2 o; o.x = v.x < 0.f ? m.x : r.x; o.y = v.y < 0.f ? m.y : r.y; return o;
}

template <int ACT  > struct EpiBf16 {
    static constexpr bool PERM = true, AFTER_DRAIN = false, APERM = false; static_assert(ACT == 0 || ACT == 1, "EpiBf16: ACT is 0 (none) or 1 (gelu_pk)");
    bf16_t* O; int ldc; const float* bias; int split_cols; size_t split_stride; float scale0;
    __device__ __forceinline__ void operator()(const f32x4 (&acc)[2][2][4][2], const Unit& u, int wr, int wc, int fr, int fq) const {
        const int row0 = u.pm * BM + wr * 64 + fr; int colt = u.pn * BM; bf16_t* base = O;
        float sc = 1.f; if (split_cols) { const int t = colt / split_cols; base += (size_t)t * split_stride; colt -= t * split_cols; if (t == 0) sc = scale0; }
        const int col0 = colt + wc * 32 + 8 * fq, bcol0 = u.pn * BM + wc * 32 + 8 * fq;
        f32x4 bv[2][2];
#pragma unroll
        for (int bj = 0; bj < 2; ++bj)
#pragma unroll
            for (int n = 0; n < 2; ++n) bv[bj][n] = bias ? *(const f32x4*)(bias + bcol0 + bj * HALF + 4 * n) : (f32x4){0.f, 0.f, 0.f, 0.f};
#pragma unroll
        for (int ai = 0; ai < 2; ++ai)
#pragma unroll
            for (int m = 0; m < 4; ++m) { bf16_t* rowp = base + (size_t)(row0 + ai * HALF + m * 16) * ldc + col0;
#pragma unroll
                for (int bj = 0; bj < 2; ++bj) { f32x4 v0 = acc[ai][bj][m][0] + bv[bj][0], v1 = acc[ai][bj][m][1] + bv[bj][1];
                    if (ACT == 1) { f32x2 a = gelu_pk((f32x2){v0[0], v0[1]}), b = gelu_pk((f32x2){v0[2], v0[3]}), c = gelu_pk((f32x2){v1[0], v1[1]}), d = gelu_pk((f32x2){v1[2], v1[3]});
                        v0 = (f32x4){a.x, a.y, b.x, b.y}; v1 = (f32x4){c.x, c.y, d.x, d.y}; }
                    v0 = v0 * sc; v1 = v1 * sc; u32x4 w; w.x = cvt_pk_bf16(v0[0], v0[1]); w.y = cvt_pk_bf16(v0[2], v0[3]); w.z = cvt_pk_bf16(v1[0], v1[1]); w.w = cvt_pk_bf16(v1[2], v1[3]);
                    *(u32x4*)(rowp + bj * HALF) = w; } }
    }
};

typedef unsigned u32x2 __attribute__((ext_vector_type(2)));
#define PG8_DPP(oldv, src, ctrl, bc) __builtin_bit_cast(float, __builtin_amdgcn_update_dpp(__builtin_bit_cast(int, (float)(oldv)), __builtin_bit_cast(int, (float)(src)), (ctrl), 0xf, 0xf, (bc)))


__device__ __forceinline__ int na_kappa(int x) { return (x & ~12) | ((x & 8) >> 1) | ((x & 4) << 1); }
struct EpiFragQK {
    static constexpr bool PERM = true, AFTER_DRAIN = false, APERM = false;
    bf16_t* O; float scale_q;
    __device__ __forceinline__ void operator()(const f32x4 (&acc)[2][2][4][2], const Unit& u, int wr, int wc, int fr, int fq) const {
#pragma unroll
        for (int bj = 0; bj < 2; ++bj) { const int col8 = u.pn * BM + bj * HALF + wc * 32 + 8 * fq, which = col8 >> 10, h = (col8 >> 6) & 15, d0 = col8 & 63, ds = d0 >> 4, hh = (d0 >> 3) & 1;
            const float sc = which ? 1.f : scale_q;
#pragma unroll
            for (int ai = 0; ai < 2; ++ai)
#pragma unroll
                for (int m = 0; m < 4; ++m) { const int row = u.pm * BM + ai * HALF + wr * 64 + m * 16 + fr, b = row >> 12, r = (row >> 6) & 63, c = row & 63, t32 = c >> 5, c31 = c & 31;
                    const int rho = which ? na_kappa(c31) : c31;
                    const size_t fi = (((((size_t)(which * 4 + b) * 16 + h) * 64 + r) * 2 + t32) * 4 + ds); const size_t addr = fi * 512 + (rho + 32 * hh) * 8;
                    const f32x4 v0 = acc[ai][bj][m][0] * sc, v1 = acc[ai][bj][m][1] * sc;
                    u32x4 w; w.x = cvt_pk_bf16(v0[0], v0[1]); w.y = cvt_pk_bf16(v0[2], v0[3]); w.z = cvt_pk_bf16(v1[0], v1[1]); w.w = cvt_pk_bf16(v1[2], v1[3]);
                    *(u32x4*)(O + addr) = w; } }
    }
};
struct EpiVHy {
    static constexpr bool PERM = true, AFTER_DRAIN = false, APERM = false;
    bf16_t* O; int ldc;
    __device__ __forceinline__ void operator()(const f32x4 (&acc)[2][2][4][2], const Unit& u, int wr, int wc, int fr, int fq) const {
#pragma unroll
        for (int bj = 0; bj < 2; ++bj) { const int col8 = u.pn * BM + bj * HALF + wc * 32 + 8 * fq, b = col8 >> 12, kr = (col8 >> 6) & 63, c = col8 & 63, kt = c >> 5, s2 = (c >> 4) & 1, hh = (c >> 3) & 1;
#pragma unroll
            for (int ai = 0; ai < 2; ++ai)
#pragma unroll
                for (int m = 0; m < 4; ++m) { const int ch = u.pm * BM + ai * HALF + wr * 64 + m * 16 + fr; size_t addr;
                    if (u.pm < 4) { const int h = ch >> 6, d = ch & 63, dt = d >> 5;
                        const size_t fi = (((((size_t)(b * 16 + h) * 64 + kr) * 2 + kt) * 2 + dt) * 2 + s2); addr = fi * 512 + ((d & 31) + 32 * hh) * 8; }
                    else addr = (size_t)ch * ldc + col8;
                    const f32x4 v0 = acc[ai][bj][m][0], v1 = acc[ai][bj][m][1];
                    u32x4 w; w.x = cvt_pk_bf16(v0[0], v0[1]); w.y = cvt_pk_bf16(v0[2], v0[3]); w.z = cvt_pk_bf16(v1[0], v1[1]); w.w = cvt_pk_bf16(v1[2], v1[3]);
                    *(u32x4*)(O + addr) = w; } }
    }
};
struct EpiRes1 {
    static constexpr bool PERM = true, AFTER_DRAIN = false, APERM = false;
    const float* xin; bf16_t* x1; bf16_t* a2; const float* gate; int gate_stride; const float* gmul; float* ssq; int ldc; PG8_LAS float* gl;
    __device__ __forceinline__ void operator()(const f32x4 (&acc)[2][2][4][2], const Unit& u, int wr, int wc, int fr, int fq) const {
        const int b = u.pm >> 4;
        const int row0 = u.pm * BM + wr * 64 + fr, col0 = u.pn * BM + wc * 32 + 8 * fq;
        PG8_LAS float* glw = gl + (wr * 4 + wc) * 128 + fq * 4;
        {   f32x4 gv[2][2], mv[2][2];
#pragma unroll
            for (int bj = 0; bj < 2; ++bj)
#pragma unroll
                for (int n = 0; n < 2; ++n) { gv[bj][n] = *(const f32x4*)(gate + (size_t)b * gate_stride + col0 + bj * HALF + n * 4); mv[bj][n] = *(const f32x4*)(gmul + (size_t)b * ldc + col0 + bj * HALF + n * 4); }
            if (fr == 0) {
#pragma unroll
                for (int bj = 0; bj < 2; ++bj)
#pragma unroll
                    for (int n = 0; n < 2; ++n) { *(PG8_LAS f32x4*)(glw + (bj * 2 + n) * 16) = gv[bj][n]; *(PG8_LAS f32x4*)(glw + 64 + (bj * 2 + n) * 16) = mv[bj][n]; } }
            asm volatile("s_waitcnt lgkmcnt(0)" ::: "memory");
        }
#ifndef RES1_NS
#define RES1_NS 3
#endif
        f32x4 xv[RES1_NS][2][2]; float sq[4];
#define RES1_LOAD(k_) do { constexpr int ai_ = (k_) >> 2, bj_ = ((k_) >> 1) & 1, mh_ = (k_) & 1; _Pragma("unroll") for (int mm = 0; mm < 2; ++mm) _Pragma("unroll") for (int n = 0; n < 2; ++n) \
            xv[(k_) % RES1_NS][mm][n] = __builtin_nontemporal_load((const f32x4*)(xin + (size_t)(row0 + ai_ * HALF + (2 * mh_ + mm) * 16) * ldc + col0 + bj_ * HALF + n * 4)); asm volatile("" ::: "memory"); } while (0)
#define RES1_PROC(k_) do { constexpr int ai_ = (k_) >> 2, bj_ = ((k_) >> 1) & 1, mh_ = (k_) & 1; u32x4 w1[2], w2[2]; \
            _Pragma("unroll") for (int mm = 0; mm < 2; ++mm) { const int m = 2 * mh_ + mm; float s = bj_ ? sq[m] : 0.f; \
                _Pragma("unroll") for (int n = 0; n < 2; ++n) { const f32x4 v = xv[(k_) % RES1_NS][mm][n] + *(const PG8_LAS f32x4*)(glw + (bj_ * 2 + n) * 16) * acc[ai_][bj_][m][n]; \
                    s += (v[0] * v[0] + v[1] * v[1]) + (v[2] * v[2] + v[3] * v[3]); \
                    const f32x4 a = v * *(const PG8_LAS f32x4*)(glw + 64 + (bj_ * 2 + n) * 16); \
                    if (n == 0) { w1[mm].x = cvt_pk_bf16(v[0], v[1]); w1[mm].y = cvt_pk_bf16(v[2], v[3]); w2[mm].x = cvt_pk_bf16(a[0], a[1]); w2[mm].y = cvt_pk_bf16(a[2], a[3]); } \
                    else { w1[mm].z = cvt_pk_bf16(v[0], v[1]); w1[mm].w = cvt_pk_bf16(v[2], v[3]); w2[mm].z = cvt_pk_bf16(a[0], a[1]); w2[mm].w = cvt_pk_bf16(a[2], a[3]); } } \
                sq[m] = s; } \
            asm volatile("" ::: "memory"); \
            if constexpr ((k_) + RES1_NS < 8) RES1_LOAD((k_) + RES1_NS); \
            _Pragma("unroll") for (int mm = 0; mm < 2; ++mm) { const size_t off = (size_t)(row0 + ai_ * HALF + (2 * mh_ + mm) * 16) * ldc + col0 + bj_ * HALF; *(u32x4*)(x1 + off) = w1[mm]; *(u32x4*)(a2 + off) = w2[mm]; \
                if (bj_) { float s = sq[2 * mh_ + mm]; s += __shfl_xor(s, 16); s += __shfl_xor(s, 32); if (fq == 0) atomicAdd(ssq + row0 + ai_ * HALF + (2 * mh_ + mm) * 16, s); } } \
            asm volatile("" ::: "memory"); } while (0)
        RES1_LOAD(0); RES1_LOAD(1); if constexpr (RES1_NS > 2) RES1_LOAD(2); if constexpr (RES1_NS > 3) RES1_LOAD(3);
        RES1_PROC(0); RES1_PROC(1); RES1_PROC(2); RES1_PROC(3); RES1_PROC(4); RES1_PROC(5); RES1_PROC(6); RES1_PROC(7);
#undef RES1_PROC
#undef RES1_LOAD
    }
};
struct EpiRes2 {
    static constexpr bool PERM = true, AFTER_DRAIN = false, APERM = false;
    const bf16_t* x1; bf16_t* x2; const float* gate; int gate_stride; int ldc;
    __device__ __forceinline__ void operator()(const f32x4 (&acc)[2][2][4][2], const Unit& u, int wr, int wc, int fr, int fq) const {
        const int b = u.pm >> 4;
        const int row0 = u.pm * BM + wr * 64 + fr, col0 = u.pn * BM + wc * 32 + 8 * fq;
        f32x4 gv[2][2];
#pragma unroll
        for (int bj = 0; bj < 2; ++bj)
#pragma unroll
            for (int n = 0; n < 2; ++n) gv[bj][n] = *(const f32x4*)(gate + (size_t)b * gate_stride + col0 + bj * HALF + n * 4);
        u32x4 xw[2][4][2];
#define RES2_LOAD(ai_) do { _Pragma("unroll") for (int m = 0; m < 4; ++m) _Pragma("unroll") for (int bj = 0; bj < 2; ++bj) \
            xw[ai_][m][bj] = __builtin_nontemporal_load((const u32x4*)(x1 + (size_t)(row0 + (ai_) * HALF + m * 16) * ldc + col0 + bj * HALF)); asm volatile("" ::: "memory"); } while (0)
        RES2_LOAD(0); RES2_LOAD(1);
#pragma unroll
        for (int ai = 0; ai < 2; ++ai)
#pragma unroll
            for (int m = 0; m < 4; ++m) { const size_t off = (size_t)(row0 + ai * HALF + m * 16) * ldc + col0;
#pragma unroll
                for (int bj = 0; bj < 2; ++bj) { const u32x4 xq = xw[ai][m][bj];
                    const f32x4 xv0 = {__builtin_bit_cast(float, xq.x << 16), __builtin_bit_cast(float, xq.x & 0xffff0000u), __builtin_bit_cast(float, xq.y << 16), __builtin_bit_cast(float, xq.y & 0xffff0000u)};
                    const f32x4 xv1 = {__builtin_bit_cast(float, xq.z << 16), __builtin_bit_cast(float, xq.z & 0xffff0000u), __builtin_bit_cast(float, xq.w << 16), __builtin_bit_cast(float, xq.w & 0xffff0000u)};
                    const f32x4 v0 = xv0 + gv[bj][0] * acc[ai][bj][m][0], v1 = xv1 + gv[bj][1] * acc[ai][bj][m][1];
                    u32x4 w; w.x = cvt_pk_bf16(v0[0], v0[1]); w.y = cvt_pk_bf16(v0[2], v0[3]); w.z = cvt_pk_bf16(v1[0], v1[1]); w.w = cvt_pk_bf16(v1[2], v1[3]);
                    *(u32x4*)(x2 + off + bj * HALF) = w; }
                asm volatile("" ::: "memory"); }
#undef RES2_LOAD
    }
};
__device__ __forceinline__ f32x2 gelu2s(f32x2 vs) {
    f32x2 t; t.x = __builtin_amdgcn_rcpf(__builtin_fmaf(__builtin_fabsf(vs.x), 0.27273748088f, 1.0f)); t.y = __builtin_amdgcn_rcpf(__builtin_fmaf(__builtin_fabsf(vs.y), 0.27273748088f, 1.0f));
    f32x2 q = t * (-1.061405429f) + 1.453152027f; q = q * t + (-1.421413741f); q = q * t + 0.284496736f; q = q * t + (-0.254829592f); q = q * t;
    const f32x2 s = vs * vs;
    f32x2 e; e.x = __builtin_amdgcn_exp2f(-s.x); e.y = __builtin_amdgcn_exp2f(-s.y);
    const f32x2 h = q * e + 1.0f;
    f32x2 o; o.x = __builtin_fmaf(__builtin_fabsf(vs.x), h.x, vs.x); o.y = __builtin_fmaf(__builtin_fabsf(vs.y), h.y, vs.y); return o;
}

struct EpiGlu {
    static constexpr bool PERM = true, AFTER_DRAIN = false, APERM = true;
    bf16_t* gated; const float* ssq; const float* biasU; const float* cw; const float* cb; float* edgeA; float* edgeB; PG8_LAS float* xch; int ldo;
    __device__ __forceinline__ void operator()(f32x4 (&acc)[2][2][4][2], const Unit& u, int wr, int wc, int fr, int fq) const {
        constexpr float SK = 0.84932180029f, GS = 0.58870501126f;
        const int b = u.pm >> 4;
        const int lcol0 = wc * 32 + 8 * fq, jcol0 = u.pn * HALF + lcol0;
        {
            f32x4 bu[2][2];
#pragma unroll
            for (int bj = 0; bj < 2; ++bj)
#pragma unroll
                for (int n = 0; n < 2; ++n) bu[bj][n] = *(const f32x4*)(biasU + (size_t)b * 11264 + u.pn * BM + bj * HALF + lcol0 + 4 * n);
#pragma unroll
            for (int n = 0; n < 2; ++n) bu[1][n] = bu[1][n] * GS;
#pragma unroll
            for (int ai = 0; ai < 2; ++ai) { const f32x4 q4 = *(const f32x4*)(ssq + u.pm * BM + ai * HALF + wr * 64 + 4 * fr);
#pragma unroll
                for (int m = 0; m < 4; ++m) { const float rs = __builtin_amdgcn_rsqf(q4[m] * (1.0f / 2048.0f) + 1e-6f), rg = rs * GS;
#pragma unroll
                    for (int n = 0; n < 2; ++n) { acc[ai][0][m][n] = acc[ai][0][m][n] * rs + bu[0][n]; acc[ai][1][m][n] = acc[ai][1][m][n] * rg + bu[1][n]; } } }
        }
#pragma unroll
        for (int ai = 0; ai < 2; ++ai) { const int seg = 2 * ai + wr;
#pragma unroll
            for (int n = 0; n < 2; ++n) {
                if (fr == 0) *(PG8_LAS f32x4*)(xch + (seg * 2 + 0) * 128 + lcol0 + 4 * n) = acc[ai][0][0][n];
                if (fr == 15) *(PG8_LAS f32x4*)(xch + (seg * 2 + 1) * 128 + lcol0 + 4 * n) = acc[ai][0][3][n];
            } }
        if (wr == 0) {
            if (fr == 0) {
#pragma unroll
                for (int n = 0; n < 2; ++n) { *(f32x4*)(edgeA + ((size_t)u.pm * 4 + 0) * ldo + jcol0 + 4 * n) = acc[0][0][0][n]; *(f32x4*)(edgeA + ((size_t)u.pm * 4 + 1) * ldo + jcol0 + 4 * n) = acc[0][0][1][n];
                                              *(f32x4*)(edgeB + ((size_t)u.pm * 2 + 0) * ldo + jcol0 + 4 * n) = acc[0][1][0][n] * (1.0f / GS); } }
        } else {
            if (fr == 15) {
#pragma unroll
                for (int n = 0; n < 2; ++n) { *(f32x4*)(edgeA + ((size_t)u.pm * 4 + 2) * ldo + jcol0 + 4 * n) = acc[1][0][2][n]; *(f32x4*)(edgeA + ((size_t)u.pm * 4 + 3) * ldo + jcol0 + 4 * n) = acc[1][0][3][n];
                                              *(f32x4*)(edgeB + ((size_t)u.pm * 2 + 1) * ldo + jcol0 + 4 * n) = acc[1][1][3][n] * (1.0f / GS); } }
        }
        asm volatile("s_waitcnt lgkmcnt(0)" ::: "memory"); __builtin_amdgcn_s_barrier(); asm volatile("" ::: "memory");
        u32x2 w_lo[2][4];
#pragma unroll
        for (int n = 0; n < 2; ++n) {
            const f32x4 w0 = *(const f32x4*)(cw + jcol0 + 4 * n) * SK, w1 = *(const f32x4*)(cw + ldo + jcol0 + 4 * n) * SK, w2 = *(const f32x4*)(cw + 2 * ldo + jcol0 + 4 * n) * SK, cbv = *(const f32x4*)(cb + jcol0 + 4 * n) * SK;
#pragma unroll
            for (int ai = 0; ai < 2; ++ai) { const int seg = 2 * ai + wr;
                f32x4 xp = (f32x4){0.f, 0.f, 0.f, 0.f}, xn = (f32x4){0.f, 0.f, 0.f, 0.f};
                if (seg > 0) xp = *(const PG8_LAS f32x4*)(xch + ((seg - 1) * 2 + 1) * 128 + lcol0 + 4 * n);
                if (seg < 3) xn = *(const PG8_LAS f32x4*)(xch + ((seg + 1) * 2 + 0) * 128 + lcol0 + 4 * n);
#pragma unroll
                for (int e = 0; e < 4; ++e) { xp[e] = PG8_DPP(xp[e], acc[ai][0][3][n][e], 0x111, false);
                                              xn[e] = PG8_DPP(xn[e], acc[ai][0][0][n][e], 0x101, false); }
#pragma unroll
                for (int m = 0; m < 4; ++m) { const f32x4 cur = acc[ai][0][m][n], pv = m > 0 ? acc[ai][0][m > 0 ? m - 1 : 0][n] : xp, nv = m < 3 ? acc[ai][0][m < 3 ? m + 1 : 3][n] : xn;
                    const f32x4 cv = w0 * pv + w1 * cur + w2 * nv + cbv;
                    const f32x2 g0 = gelu2s((f32x2){cv[0], cv[1]}), g1 = gelu2s((f32x2){cv[2], cv[3]});
                    const f32x4 bb = acc[ai][1][m][n];
                    const f32x2 r0 = g0 * (f32x2){bb[0], bb[1]}, r1 = g1 * (f32x2){bb[2], bb[3]};
                    u32x2 w; w.x = cvt_pk_bf16(r0.x, r0.y); w.y = cvt_pk_bf16(r1.x, r1.y);
                    if (n == 0) w_lo[ai][m] = w;
                    else { const int row = u.pm * BM + ai * HALF + wr * 64 + 4 * fr + m;
                        u32x4 o; o.x = w_lo[ai][m].x; o.y = w_lo[ai][m].y; o.z = w.x; o.w = w.y;
                        __builtin_nontemporal_store(o, (u32x4*)(gated + (size_t)row * ldo + jcol0)); } }
            } }
    }
};
#ifdef CLK_PROBE
__device__ unsigned long long pg8_probe_epi;
#endif
template <class Epi, class Sched, bool ALIGN_EPI = false, bool SP2 = false>
__device__ __forceinline__ void gemm_phase(PG8_LAS unsigned char* lds, const Gemm g, const Sched& S, const Epi& E) {
    const int tid = threadIdx.x, wid = __builtin_amdgcn_readfirstlane(tid >> 6), lane = tid & 63, wr = wid >> 2, wc = wid & 3, fr = lane & 15, fq = lane >> 4;
    const int K = g.K, nt = K / BK;
    unsigned voffA[2], voffB[2];
#pragma unroll
    for (int i = 0; i < 2; ++i) { int R, C; stage_rc(tid * 16 + i * 8192, R, C); const int Rb = Epi::PERM ? ((R & ~31) + perm32(R & 31)) : R;
        const int Ra = Epi::APERM ? ((R & ~63) + 4 * (R & 15) + ((R >> 4) & 3)) : R;
        voffA[i] = (unsigned)(Ra * K + C) * 2u; voffB[i] = (unsigned)(Rb * K + C) * 2u; }
    const size_t kstep = (size_t)(BK * 2);
    const size_t hstep = (size_t)HALF * K * 2;
    const size_t tstep = 2 * hstep;
    const unsigned ldsw = (unsigned)wid * 1024u;
    const int aoff = lds_byte(wr * 64 + fr, fq * 8), boff = lds_byte(wc * 32 + fr, fq * 8);
#define PG8_SA(b, h) (((b) * 2 + (h)) * HTB)
#define PG8_SB(b, h) ((4 + (b) * 2 + (h)) * HTB)
#define PG8_STAGE(bufoff, gbase, voff) do { _Pragma("unroll") for (int _i = 0; _i < 2; ++_i) \
        __builtin_amdgcn_global_load_lds((const unsigned*)((const char*)(gbase) + (voff)[_i]), (PG8_LAS unsigned*)(lds + (bufoff) + ldsw + _i * 8192), 16, 0, 0); } while (0)
#define PG8_LDA(dst, b, h) do { _Pragma("unroll") for (int m = 0; m < 4; ++m) _Pragma("unroll") for (int k = 0; k < 2; ++k) dst[m][k] = *(const PG8_LAS bf16x8*)(lds + PG8_SA(b, h) + aoff + m * 2048 + k * 1024); } while (0)
#define PG8_LDB(dst, b, h) do { _Pragma("unroll") for (int n = 0; n < 2; ++n) _Pragma("unroll") for (int k = 0; k < 2; ++k) dst[n][k] = *(const PG8_LAS bf16x8*)(lds + PG8_SB(b, h) + boff + n * 2048 + k * 1024); } while (0)
#define PG8_MMA(ai, bj, At, Bt) do { __builtin_amdgcn_s_setprio(1); _Pragma("unroll") for (int m = 0; m < 4; ++m) _Pragma("unroll") for (int n = 0; n < 2; ++n) _Pragma("unroll") for (int k = 0; k < 2; ++k) \
        acc[ai][bj][m][n] = __builtin_amdgcn_mfma_f32_16x16x32_bf16(Bt[n][k], At[m][k], acc[ai][bj][m][n], 0, 0, 0); __builtin_amdgcn_s_setprio(0); } while (0)
#define PG8_WAIT_V(n) asm volatile("s_waitcnt vmcnt(" #n ")" ::: "memory")
#define PG8_WAIT_L(n) asm volatile("s_waitcnt lgkmcnt(" #n ")" ::: "memory")
#define PG8_BAR __builtin_amdgcn_s_barrier()
#define PG8_SCHED __builtin_amdgcn_sched_barrier(0)
    Unit cur, nxt; int ui = 0;
    if (!S.next(0, cur)) return;
    f32x4 acc[2][2][4][2];
#pragma unroll
    for (int a = 0; a < 2; ++a)
#pragma unroll
        for (int b = 0; b < 2; ++b)
#pragma unroll
            for (int m = 0; m < 4; ++m)
#pragma unroll
                for (int n = 0; n < 2; ++n) acc[a][b][m][n] = (f32x4){0.f, 0.f, 0.f, 0.f};
    bf16x8 At[4][2], B0[2][2], B1[2][2];
    const char* cA = (const char*)g.A + (size_t)cur.pm * tstep; const char* cB = (const char*)g.Bt + (size_t)cur.pn * tstep;
    S.a_ready(cur);
    if constexpr (SP2) {
        PG8_STAGE(PG8_SB(0, 0), cB, voffB); PG8_STAGE(PG8_SB(0, 1), cB + hstep, voffB); PG8_STAGE(PG8_SA(0, 0), cA, voffA); PG8_STAGE(PG8_SA(0, 1), cA + hstep, voffA);
        if (wr == 1) PG8_BAR;
        PG8_WAIT_V(2); PG8_BAR;
        PG8_STAGE(PG8_SB(1, 0), cB + kstep, voffB); PG8_STAGE(PG8_SA(1, 0), cA + kstep, voffA); PG8_STAGE(PG8_SB(1, 1), cB + hstep + kstep, voffB);
        PG8_WAIT_V(6); PG8_BAR;
    } else {
        PG8_STAGE(PG8_SB(0, 0), cB, voffB); PG8_STAGE(PG8_SA(0, 0), cA, voffA); PG8_STAGE(PG8_SB(0, 1), cB + hstep, voffB); PG8_STAGE(PG8_SA(0, 1), cA + hstep, voffA);
        if (wr == 1) PG8_BAR;
        PG8_WAIT_V(4); PG8_BAR;
        PG8_STAGE(PG8_SB(1, 0), cB + kstep, voffB); PG8_STAGE(PG8_SA(1, 0), cA + kstep, voffA); PG8_STAGE(PG8_SB(1, 1), cB + hstep + kstep, voffB);
        PG8_WAIT_V(6); PG8_BAR;
    }
    for (;;) {
        const bool has_next = S.next(ui + 1, nxt);
        const char* nA = has_next ? (const char*)g.A + (size_t)nxt.pm * tstep : cA; const char* nB = has_next ? (const char*)g.Bt + (size_t)nxt.pn * tstep : cB;
#if defined(CLK_PROBE) && CLK_PROBE == 5
        const unsigned long long pr_k0 = __builtin_amdgcn_s_memtime();
#endif
        for (int t = 0; t < nt; t += 2) {
            const bool last = (t == nt - 2);
            const char* a1 = cA + (size_t)(t + 1) * kstep;
            const char* a2 = last ? nA : cA + (size_t)(t + 2) * kstep; const char* b2 = last ? nB : cB + (size_t)(t + 2) * kstep;
            const char* a3 = a2 + kstep; const char* b3 = b2 + kstep;
            if (last && has_next) S.a_ready(nxt);
            if constexpr (SP2) {
            PG8_LDB(B0, 0, 0); PG8_LDB(B1, 0, 1); PG8_SCHED; PG8_LDA(At, 0, 0); PG8_STAGE(PG8_SA(1, 1), a1 + hstep, voffA);
            PG8_WAIT_V(8); PG8_WAIT_L(0); PG8_BAR; PG8_MMA(0, 0, At, B0); PG8_MMA(0, 1, At, B1); PG8_BAR; PG8_SCHED;
            PG8_LDA(At, 0, 1); PG8_STAGE(PG8_SB(0, 0), b2, voffB); PG8_STAGE(PG8_SB(0, 1), b2 + hstep, voffB); PG8_STAGE(PG8_SA(0, 0), a2, voffA);
            PG8_WAIT_V(8); PG8_WAIT_L(0); PG8_BAR; PG8_MMA(1, 0, At, B0); PG8_MMA(1, 1, At, B1); PG8_BAR; PG8_SCHED;
            PG8_LDB(B0, 1, 0); PG8_LDB(B1, 1, 1); PG8_SCHED; PG8_LDA(At, 1, 0); PG8_STAGE(PG8_SA(0, 1), a2 + hstep, voffA);
            PG8_WAIT_V(8); PG8_WAIT_L(0); PG8_BAR; PG8_MMA(0, 0, At, B0); PG8_MMA(0, 1, At, B1); PG8_BAR; PG8_SCHED;
            PG8_LDA(At, 1, 1); PG8_STAGE(PG8_SB(1, 0), b3, voffB); PG8_STAGE(PG8_SB(1, 1), b3 + hstep, voffB); PG8_STAGE(PG8_SA(1, 0), a3, voffA);
            PG8_WAIT_V(8); PG8_WAIT_L(0); PG8_BAR; PG8_MMA(1, 0, At, B0); PG8_MMA(1, 1, At, B1); PG8_BAR; PG8_SCHED;
            } else {
            PG8_LDB(B0, 0, 0); PG8_SCHED; PG8_LDA(At, 0, 0); PG8_STAGE(PG8_SA(1, 1), a1 + hstep, voffA);
            PG8_WAIT_L(8); PG8_BAR; PG8_WAIT_L(0); PG8_MMA(0, 0, At, B0); PG8_BAR; PG8_SCHED;
            PG8_LDB(B1, 0, 1); PG8_STAGE(PG8_SB(0, 0), b2, voffB);
            PG8_BAR; PG8_WAIT_L(0); PG8_MMA(0, 1, At, B1); PG8_BAR;
            PG8_LDA(At, 0, 1); PG8_STAGE(PG8_SA(0, 0), a2, voffA);
            PG8_BAR; PG8_WAIT_L(0); PG8_MMA(1, 0, At, B0); PG8_BAR; PG8_SCHED;
            PG8_STAGE(PG8_SB(0, 1), b2 + hstep, voffB);
            PG8_WAIT_V(6); PG8_BAR; PG8_MMA(1, 1, At, B1); PG8_BAR;
            PG8_LDB(B0, 1, 0); PG8_SCHED; PG8_LDA(At, 1, 0); PG8_STAGE(PG8_SA(0, 1), a2 + hstep, voffA);
            PG8_WAIT_L(8); PG8_BAR; PG8_WAIT_L(0); PG8_MMA(0, 0, At, B0); PG8_BAR; PG8_SCHED;
            PG8_LDB(B1, 1, 1); PG8_STAGE(PG8_SB(1, 0), b3, voffB);
            PG8_BAR; PG8_WAIT_L(0); PG8_MMA(0, 1, At, B1); PG8_BAR;
            PG8_LDA(At, 1, 1); PG8_STAGE(PG8_SA(1, 0), a3, voffA);
            PG8_BAR; PG8_WAIT_L(0); PG8_MMA(1, 0, At, B0); PG8_BAR; PG8_SCHED;
            PG8_STAGE(PG8_SB(1, 1), b3 + hstep, voffB);
            PG8_WAIT_V(6); PG8_BAR; PG8_MMA(1, 1, At, B1); PG8_BAR;
            }
        }
#if defined(CLK_PROBE) && CLK_PROBE == 5
        if (blockIdx.x == 0 && tid == 0) atomicAdd(&pg8_probe_epi, __builtin_amdgcn_s_memtime() - pr_k0);
#endif
        if constexpr (ALIGN_EPI) { if (wr == 0) PG8_BAR; }
#if defined(CLK_PROBE) && CLK_PROBE != 5
        const unsigned long long pr_t0 = __builtin_amdgcn_s_memtime();
#endif
        if constexpr (!Epi::AFTER_DRAIN) { E(acc, cur, wr, wc, fr, fq); S.done(cur); }
#if defined(CLK_PROBE) && CLK_PROBE != 5
        if (blockIdx.x == 0 && tid == 0) atomicAdd(&pg8_probe_epi, __builtin_amdgcn_s_memtime() - pr_t0);
#endif
        if (!has_next) break;
#pragma unroll
        for (int a = 0; a < 2; ++a)
#pragma unroll
            for (int b = 0; b < 2; ++b)
#pragma unroll
                for (int m = 0; m < 4; ++m)
#pragma unroll
                    for (int n = 0; n < 2; ++n) acc[a][b][m][n] = (f32x4){0.f, 0.f, 0.f, 0.f};
        cur = nxt; cA = nA; cB = nB; ++ui;
        if constexpr (ALIGN_EPI) { if (wr == 1) PG8_BAR; }
    }
    PG8_WAIT_V(0);
    if constexpr (!ALIGN_EPI) { if (wr == 0) PG8_BAR; }
    PG8_BAR;
    if constexpr (Epi::AFTER_DRAIN) { E.fused(acc, cur, wr, wc, fr, fq, lds, wid, lane); S.done(cur); }
#undef PG8_SA
#undef PG8_SB
#undef PG8_STAGE
#undef PG8_LDA
#undef PG8_LDB
#undef PG8_MMA
#undef PG8_WAIT_V
#undef PG8_WAIT_L
#undef PG8_BAR
#undef PG8_SCHED
}
}

#ifndef PG8_SP2
#define PG8_SP2 true
#endif
#ifndef PG8_ALIGN
#define PG8_ALIGN true
#endif
#ifndef DUP_MASK
#define DUP_MASK 0
#endif
#ifndef DUP_REPS
#define DUP_REPS 2
#endif
#define DUPN(bit) (((DUP_MASK >> (bit)) & 1) ? DUP_REPS : 1)
#ifndef MK_N_LAUNCHES
#define MK_N_LAUNCHES 1
#endif

constexpr int NB = 4, SEQ = 4096, DM = 2048, MT = NB * SEQ;
constexpr int DNA = 1024, DHY = 1024, NHEAD = 16, DFF = 5632, NMODW = 6 * DM;
constexpr float EPS = 1e-6f;
constexpr int NWAVES = 8, NTHR = 512;
constexpr int N_PHASES = 10;

constexpr size_t MiB = 1u << 20;
constexpr size_t WS_CTL = 0, CTL_ZERO_BYTES = 1 * MiB;
constexpr size_t WS_MOD = 0;
constexpr size_t WS_SSQ1 = 256 * 1024;
constexpr size_t WS_BAR = 512 * 1024;
constexpr size_t WS_BIASU = 1 * MiB;
constexpr size_t WS_GMUL2 = 1 * MiB + 256 * 1024;
constexpr size_t WS_TW = 1 * MiB + 512 * 1024;
constexpr size_t WS_H3 = 2 * MiB;
constexpr size_t WS_WTIN = 4 * MiB;
constexpr size_t WS_WTOUT = 28 * MiB;
constexpr size_t WS_WTUP = 36 * MiB;
constexpr size_t WS_WTDN = 80 * MiB;
constexpr size_t WS_EDGEA = 102 * MiB;
constexpr size_t WS_EDGEB = 108 * MiB;
constexpr size_t WS_H1 = 112 * MiB;
constexpr size_t WS_QK = 176 * MiB;
constexpr size_t WS_VTHY = 240 * MiB;
constexpr size_t WS_GATED = 176 * MiB;
constexpr size_t WS_GT = 368 * MiB;
constexpr size_t WS_NAOUT = 400 * MiB;
constexpr size_t WS_HYOT = 432 * MiB;
constexpr size_t WS_A2 = 400 * MiB;
constexpr size_t WS_END = 464 * MiB;
static_assert(WS_GATED + (size_t)MT * DFF * 2 <= WS_GT && WS_EDGEB + 64ull * 2 * DFF * 4 <= WS_H1 && WS_EDGEA + 64ull * 4 * DFF * 4 <= WS_EDGEB, "ws map");

constexpr int RING_BYTES = 131072;
constexpr int XCH_OFF = RING_BYTES;
constexpr int LDS_BYTES = 163840;
constexpr int BARST_OFF = LDS_BYTES - 64;

#define GAS __attribute__((address_space(1)))
#define LAS __attribute__((address_space(3)))
typedef unsigned short bf16;
typedef unsigned v4u __attribute__((ext_vector_type(4)));
typedef unsigned v2u __attribute__((ext_vector_type(2)));
typedef float f32x4 __attribute__((ext_vector_type(4)));
typedef float f32x2 __attribute__((ext_vector_type(2)));
typedef float f32x16 __attribute__((ext_vector_type(16)));
typedef short bf16x8 __attribute__((ext_vector_type(8)));
typedef short s16x4 __attribute__((ext_vector_type(4)));

__device__ __forceinline__ unsigned f2bf(float f) { unsigned u = __builtin_bit_cast(unsigned, f); return (u + 0x7fffu + ((u >> 16) & 1u)) >> 16; }
__device__ __forceinline__ unsigned pk2(float lo, float hi) { typedef __bf16 bf2v_t __attribute__((ext_vector_type(2))); const f32x2 v = {lo, hi}; return __builtin_bit_cast(unsigned, __builtin_convertvector(v, bf2v_t)); }
__device__ __forceinline__ float bf2f(unsigned short h) { return __builtin_bit_cast(float, (unsigned)h << 16); }
__device__ __forceinline__ float bflo(unsigned w) { return __builtin_bit_cast(float, w << 16); }
__device__ __forceinline__ float bfhi(unsigned w) { return __builtin_bit_cast(float, w & 0xffff0000u); }
__device__ __forceinline__ float wave_sum(float v) {
#pragma unroll
    for (int o = 1; o < 64; o <<= 1) v += __shfl_xor(v, o);
    return v;
}

struct Frame {
    LAS unsigned char* lds;
    int tid, lane, wave, vcu, G;
    const float* const __attribute__((address_space(4)))* in;
    float* out; unsigned char* ws;
};

struct TItem { const float* W; bf16* WT; int K, N, mode, k0, n0; };
constexpr int P0_I_IN = (DM / 64) * (6144 / 32), P0_I_OUT = (DM / 64) * (DM / 32), P0_I_UP = (DM / 64) * (2 * DFF / 32), P0_I_DN = (DFF / 64) * (DM / 32);
constexpr int P0_NITEMS = P0_I_IN + P0_I_OUT + P0_I_UP + P0_I_DN, P0_SPLIT = P0_I_IN + P0_I_OUT;
__device__ __forceinline__ TItem p0_decode(Frame& F, int it) {
    TItem T; int r = it;
    if (r < P0_I_IN) { T.W = F.in[5]; T.WT = (bf16*)(F.ws + WS_WTIN); T.K = DM; T.N = 6144; T.mode = 0; }
    else if ((r -= P0_I_IN) < P0_I_OUT) { T.W = F.in[20]; T.WT = (bf16*)(F.ws + WS_WTOUT); T.K = DM; T.N = DM; T.mode = 1; }
    else if ((r -= P0_I_OUT) < P0_I_UP) { T.W = F.in[22]; T.WT = (bf16*)(F.ws + WS_WTUP); T.K = DM; T.N = 2 * DFF; T.mode = 2; }
    else { r -= P0_I_UP; T.W = F.in[25]; T.WT = (bf16*)(F.ws + WS_WTDN); T.K = DFF; T.N = DM; T.mode = 0; }
    const int nblk = T.N / 32; T.k0 = 64 * (r / nblk); T.n0 = 32 * (r % nblk);
    return T;
}
__device__ __forceinline__ void p0_load(const TItem& T, int lane, f32x4 (&v)[8]) {
#pragma unroll
    for (int i = 0; i < 8; ++i) v[i] = __builtin_nontemporal_load((const f32x4*)(T.W + (size_t)(T.k0 + 8 * i + (lane >> 3)) * T.N + T.n0 + 4 * (lane & 7)));
}
__device__ __forceinline__ void p0_store(const TItem& T, LAS float* scr, int lane, const f32x4 (&v)[8], const float* beta0, const float* beta1) {
#pragma unroll
    for (int i = 0; i < 8; ++i) { LAS float* d = scr + (8 * i + (lane >> 3)) * 33 + 4 * (lane & 7); d[0] = v[i][0]; d[1] = v[i][1]; d[2] = v[i][2]; d[3] = v[i][3]; }
    asm volatile("s_waitcnt lgkmcnt(0)" ::: "memory");
    const int c = lane & 7;
    float sc[8];
#pragma unroll
    for (int i = 0; i < 8; ++i) { sc[i] = 1.f; if (T.mode == 1) { const int k = T.k0 + 8 * c + i; sc[i] = k < 1024 ? beta0[k] : beta1[k - 1024]; } }
#pragma unroll
    for (int j = 0; j < 4; ++j) { const int n = (lane >> 3) + 8 * j; const LAS float* s = scr + (8 * c) * 33 + n;
        v4u o; o.x = pk2(s[0 * 33] * sc[0], s[1 * 33] * sc[1]); o.y = pk2(s[2 * 33] * sc[2], s[3 * 33] * sc[3]); o.z = pk2(s[4 * 33] * sc[4], s[5 * 33] * sc[5]); o.w = pk2(s[6 * 33] * sc[6], s[7 * 33] * sc[7]);
        int row = T.n0 + n;
        if (T.mode == 2) { const int isb = row >= DFF ? 1 : 0, j2 = row - isb * DFF; row = (j2 >> 7) * 256 + isb * 128 + (j2 & 127); }
        *(v4u*)(T.WT + (size_t)row * T.K + T.k0 + 8 * c) = o; }
    asm volatile("s_waitcnt lgkmcnt(0)" ::: "memory");
}
constexpr int P0_MLP_OFF = NWAVES * 64 * 33 * 4;
__device__ __forceinline__ void p0_mlp_pos(Frame& F, int p) {
    const LAS float* w1 = (const LAS float*)(F.lds + P0_MLP_OFF); const LAS float* b1 = w1 + 33 * 64; const LAS float* w2 = b1 + 64; const LAS float* b2 = w2 + 64 * 64;
    const LAS float* w3 = b2 + 64; const LAS float* b3 = w3 + 64 * 64; const LAS float* fq = b3 + 64;
    float* h3 = (float*)(F.ws + WS_H3);
    const float fql = fq[F.lane];
    const float tp = (float)p * (1.0f / 4095.0f), wp = (6.283185307179586f * (float)p) / 4096.0f;
    float z = 0.f;
    if (F.lane == 0) z = tp;
    else if (F.lane <= 16) { const float fr = 1e-4f + (float)(F.lane - 1) * ((15.0f - 1e-4f) / 15.0f); z = __cosf(fr * wp); }
    else if (F.lane <= 32) { const float fr = 1e-4f + (float)(F.lane - 17) * ((15.0f - 1e-4f) / 15.0f); z = -__sinf(fr * wp); }
    float acc = b1[F.lane];
#pragma unroll 11
    for (int i = 0; i < 33; ++i) acc += __builtin_bit_cast(float, __builtin_amdgcn_readlane(__builtin_bit_cast(int, z), i)) * w1[i * 64 + F.lane];
    float h = __sinf(fql * acc);
    acc = b2[F.lane];
#pragma unroll 8
    for (int i = 0; i < 64; ++i) acc += __builtin_bit_cast(float, __builtin_amdgcn_readlane(__builtin_bit_cast(int, h), i)) * w2[i * 64 + F.lane];
    h = __sinf(fql * acc);
    acc = b3[F.lane];
#pragma unroll 8
    for (int i = 0; i < 64; ++i) acc += __builtin_bit_cast(float, __builtin_amdgcn_readlane(__builtin_bit_cast(int, h), i)) * w3[i * 64 + F.lane];
    h = __sinf(fql * acc);
    h3[p * 64 + F.lane] = h;
}

__device__ __forceinline__ void p_convert_late(Frame& F) {
    const int gw = F.vcu * NWAVES + F.wave, NGW = F.G * NWAVES;
    LAS float* scr = (LAS float*)(F.lds + F.wave * (64 * 33 * 4));
    __syncthreads();
    int it = P0_SPLIT + gw; TItem Ta, Tb; f32x4 va[8], vb[8];
    if (it < P0_NITEMS) { Ta = p0_decode(F, it); p0_load(Ta, F.lane, va); }
    while (it < P0_NITEMS) {
        const int it2 = it + NGW; const bool h2 = it2 < P0_NITEMS;
        if (h2) { Tb = p0_decode(F, it2); p0_load(Tb, F.lane, vb); }
        p0_store(Ta, scr, F.lane, va, F.in[18], F.in[19]);
        if (!h2) break;
        const int it3 = it2 + NGW; const bool h3 = it3 < P0_NITEMS;
        if (h3) { Ta = p0_decode(F, it3); p0_load(Ta, F.lane, va); }
        p0_store(Tb, scr, F.lane, vb, F.in[18], F.in[19]);
        if (!h3) break;
        it = it3;
    }
    __syncthreads();
}

__device__ __forceinline__ void p0_prologue(Frame& F) {
    const int gw = F.vcu * NWAVES + F.wave, NGW = F.G * NWAVES;
    {
        LAS float* m = (LAS float*)(F.lds + P0_MLP_OFF);
        for (int i = F.tid; i < 33 * 64; i += NTHR) m[i] = F.in[9][i];
        for (int i = F.tid; i < 64 * 64; i += NTHR) { m[33 * 64 + 64 + i] = F.in[11][i]; m[33 * 64 + 64 + 64 * 64 + 64 + i] = F.in[13][i]; }
        if (F.tid < 64) { m[33 * 64 + F.tid] = F.in[10][F.tid]; m[33 * 64 + 64 + 64 * 64 + F.tid] = F.in[12][F.tid]; m[33 * 64 + 64 + 64 * 64 + 64 + 64 * 64 + F.tid] = F.in[14][F.tid];
            m[33 * 64 + 64 + 64 * 64 + 64 + 64 * 64 + 64 + F.tid] = F.in[16][F.tid]; }
        __syncthreads();
    }
    {
        const float* cvec = F.in[1]; const float* wada = F.in[2]; const float* bada = F.in[3]; float* mod = (float*)(F.ws + WS_MOD);
        LAS float* red = (LAS float*)F.lds;
        auto mload = [&](int task, f32x4 (&w)[16]) { const int strip = task % 48, kbase = (task / 48) * 128 + F.wave * 16;
#pragma unroll
            for (int kk = 0; kk < 16; ++kk) w[kk] = __builtin_nontemporal_load((const f32x4*)(wada + (size_t)(kbase + kk) * NMODW + strip * 256 + F.lane * 4)); };
        auto mtask = [&](int task, const f32x4 (&w)[16]) { const int strip = task % 48, kc = task / 48, kbase = kc * 128 + F.wave * 16;
            f32x4 a0 = {0.f, 0.f, 0.f, 0.f}, a1 = a0, a2 = a0, a3 = a0;
#pragma unroll
            for (int kk = 0; kk < 16; ++kk) { const int k = kbase + kk;
                const float c0 = cvec[k], c1 = cvec[DM + k], c2 = cvec[2 * DM + k], c3 = cvec[3 * DM + k];
                a0 += w[kk] * (c0 / (1.f + __expf(-c0))); a1 += w[kk] * (c1 / (1.f + __expf(-c1))); a2 += w[kk] * (c2 / (1.f + __expf(-c2))); a3 += w[kk] * (c3 / (1.f + __expf(-c3))); }
            *(LAS f32x4*)(red + (F.wave * 4 + 0) * 256 + F.lane * 4) = a0; *(LAS f32x4*)(red + (F.wave * 4 + 1) * 256 + F.lane * 4) = a1;
            *(LAS f32x4*)(red + (F.wave * 4 + 2) * 256 + F.lane * 4) = a2; *(LAS f32x4*)(red + (F.wave * 4 + 3) * 256 + F.lane * 4) = a3;
            __syncthreads();
#pragma unroll
            for (int o2 = 0; o2 < 2; ++o2) { const int o = F.tid + 512 * o2, b = o >> 8, col = o & 255; float s = 0.f;
#pragma unroll
                for (int wv = 0; wv < 8; ++wv) s += red[(wv * 4 + b) * 256 + col];
                if (kc == 0) s += bada[strip * 256 + col];
                atomicAdd(mod + b * NMODW + strip * 256 + col, s); }
            __syncthreads(); };
        constexpr int NT = 48 * 16;
        int task = F.vcu; f32x4 wa[16], wb[16];
        if (task < NT) mload(task, wa);
        while (task < NT) {
            const int t2 = task + F.G; const bool h2 = t2 < NT;
            if (h2) mload(t2, wb);
            mtask(task, wa);
            if (!h2) break;
            const int t3 = t2 + F.G; const bool h3 = t3 < NT;
            if (h3) mload(t3, wa);
            mtask(t2, wb);
            if (!h3) break;
            task = t3;
        }
    }
    int mlp_p = gw;
    {
        LAS float* scr = (LAS float*)(F.lds + F.wave * (64 * 33 * 4));
        int it = gw; TItem Ta, Tb; f32x4 va[8], vb[8];
        if (it < P0_SPLIT) { Ta = p0_decode(F, it); p0_load(Ta, F.lane, va); }
        while (it < P0_SPLIT) {
            const int it2 = it + NGW; const bool h2 = it2 < P0_SPLIT;
            if (h2) { Tb = p0_decode(F, it2); p0_load(Tb, F.lane, vb); }
            if (mlp_p < SEQ) { p0_mlp_pos(F, mlp_p); mlp_p += NGW; }
            p0_store(Ta, scr, F.lane, va, F.in[18], F.in[19]);
            if (!h2) break;
            const int it3 = it2 + NGW; const bool h3 = it3 < P0_SPLIT;
            if (h3) { Ta = p0_decode(F, it3); p0_load(Ta, F.lane, va); }
            p0_store(Tb, scr, F.lane, vb, F.in[18], F.in[19]);
            if (!h3) break;
            it = it3;
        }
    }
    for (; mlp_p < SEQ; mlp_p += NGW) p0_mlp_pos(F, mlp_p);
    {
        f32x2* tw = (f32x2*)(F.ws + WS_TW);
        for (int k = F.vcu * NTHR + F.tid; k < 4096; k += F.G * NTHR) { float s, c; sincospif((float)k * (1.0f / 4096.0f), &s, &c); tw[k] = (f32x2){c, -s}; }
    }
}

__device__ __forceinline__ void p_biasu(Frame& F) {
    const int gw = F.vcu * NWAVES + F.wave, NGW = F.G * NWAVES;
    const float* mod = (const float*)(F.ws + WS_MOD);
    const bf16* wt = (const bf16*)(F.ws + WS_WTUP); float* bu = (float*)(F.ws + WS_BIASU);
    f32x4 sh[4][4][2];
#pragma unroll
    for (int b = 0; b < 4; ++b)
#pragma unroll
        for (int j = 0; j < 4; ++j) { const float* p = mod + b * NMODW + 3 * DM + 8 * F.lane + 512 * j; sh[b][j][0] = *(const f32x4*)p; sh[b][j][1] = *(const f32x4*)(p + 4); }
    v4u wn[4];
    if (gw < 2 * DFF) {
#pragma unroll
        for (int j = 0; j < 4; ++j) wn[j] = *(const v4u*)(wt + (size_t)gw * DM + 8 * F.lane + 512 * j); }
#pragma unroll 1
    for (int n = gw; n < 2 * DFF; n += NGW) {
        v4u wc[4];
#pragma unroll
        for (int j = 0; j < 4; ++j) wc[j] = wn[j];
        if (n + NGW < 2 * DFF) {
#pragma unroll
            for (int j = 0; j < 4; ++j) wn[j] = *(const v4u*)(wt + (size_t)(n + NGW) * DM + 8 * F.lane + 512 * j); }
        float sb[4] = {0.f, 0.f, 0.f, 0.f};
#pragma unroll
        for (int j = 0; j < 4; ++j) { const v4u w = wc[j];
            const f32x4 w0 = {bflo(w.x), bfhi(w.x), bflo(w.y), bfhi(w.y)}, w1 = {bflo(w.z), bfhi(w.z), bflo(w.w), bfhi(w.w)};
#pragma unroll
            for (int b = 0; b < 4; ++b) { const f32x4 t = w0 * sh[b][j][0] + w1 * sh[b][j][1]; sb[b] += (t[0] + t[1]) + (t[2] + t[3]); } }
#pragma unroll
        for (int b = 0; b < 4; ++b) sb[b] = wave_sum(sb[b]);
        if (F.lane == 0) { bu[n] = sb[0]; bu[2 * DFF + n] = sb[1]; bu[4 * DFF + n] = sb[2]; bu[6 * DFF + n] = sb[3]; }
    }
}

__device__ __forceinline__ void p_filters(Frame& F) {
    for (int rep = 0; rep < DUPN(13); ++rep) {
        const float* h3 = (const float*)(F.ws + WS_H3); const float* w4 = F.in[15]; float* Gt = (float*)(F.ws + WS_GT);
        LAS float* hT = (LAS float*)F.lds;
        LAS float* wl = (LAS float*)(F.lds + 64 * 132 * 4);
        const int tx = F.tid & 15, ty = F.tid >> 4;
        for (int task = F.vcu; task < 32 * 16; task += F.G) {
            const int p0 = (task & 31) * 128, c0 = (task >> 5) * 128;
            __syncthreads();
#pragma unroll
            for (int it = 0; it < 4; ++it) { const int idx = it * 512 + F.tid, pr = idx >> 4, k4 = (idx & 15) * 4;
                const f32x4 v = *(const f32x4*)(h3 + (size_t)(p0 + pr) * 64 + k4);
                hT[(k4 + 0) * 132 + pr] = v[0]; hT[(k4 + 1) * 132 + pr] = v[1]; hT[(k4 + 2) * 132 + pr] = v[2]; hT[(k4 + 3) * 132 + pr] = v[3]; }
#pragma unroll
            for (int it = 0; it < 4; ++it) { const int idx = it * 512 + F.tid, kr = idx >> 5, c4 = (idx & 31) * 4;
                *(LAS f32x4*)(wl + kr * 128 + c4) = *(const f32x4*)(w4 + (size_t)kr * 2048 + c0 + c4); }
            __syncthreads();
            f32x4 acc[4][2];
#pragma unroll
            for (int i = 0; i < 4; ++i) { acc[i][0] = (f32x4){0.f, 0.f, 0.f, 0.f}; acc[i][1] = (f32x4){0.f, 0.f, 0.f, 0.f}; }
#pragma unroll 8
            for (int k = 0; k < 64; ++k) { const f32x4 a = *(const LAS f32x4*)(hT + k * 132 + 4 * ty), b0 = *(const LAS f32x4*)(wl + k * 128 + 8 * tx), b1 = *(const LAS f32x4*)(wl + k * 128 + 8 * tx + 4);
#pragma unroll
                for (int i = 0; i < 4; ++i) { acc[i][0] += b0 * a[i]; acc[i][1] += b1 * a[i]; } }
            const int pb = p0 + 4 * ty;
            float tp[4];
#pragma unroll
            for (int i = 0; i < 4; ++i) tp[i] = (float)(pb + i) * (1.0f / 4095.0f);
#pragma unroll
            for (int cc = 0; cc < 8; ++cc) { const int col = c0 + 8 * tx + cc, c = col & 1023, bwd = col >> 10;
                const float dmin = -3.0701134573253945f, dmax = -15.350567286626972f;
                const float ad = fabsf(dmin + (float)c * ((dmax - dmin) / 1023.0f));
                f32x4 o;
#pragma unroll
                for (int i = 0; i < 4; ++i) o[i] = acc[i][cc >> 2][cc & 3] * __expf(-tp[i] * ad);
                *(f32x4*)(Gt + (size_t)c * 8192 + bwd * 4096 + pb) = o; }
        }
        __syncthreads();
    }
}

__device__ __forceinline__ void p1_phase(Frame& F) {
    const int gw = F.vcu * NWAVES + F.wave, NGW = F.G * NWAVES;
    const float* mod = (const float*)(F.ws + WS_MOD);
    auto part_a = [&]() {
    for (int rep = 0; rep < DUPN(12); ++rep) {
        const float* x = F.in[0]; const float* g = F.in[4]; bf16* h1 = (bf16*)(F.ws + WS_H1);
        LAS float* mulv = (LAS float*)(F.lds + 81920); LAS float* shv = mulv + NB * DM;
        __syncthreads();
        for (int i = F.tid; i < NB * DM; i += NTHR) { const int b = i >> 11, k = i & 2047; mulv[i] = g[k] * (1.0f + mod[b * NMODW + DM + k]); shv[i] = mod[b * NMODW + k]; }
        __syncthreads();
        f32x4 v[3][8];
#define P1A_LOAD(i_) do { const f32x4* xr = (const f32x4*)(x + (size_t)(gw + (i_) * NGW) * DM) + F.lane; \
            _Pragma("unroll") for (int j = 0; j < 8; ++j) v[(i_) % 3][j] = __builtin_nontemporal_load(xr + 64 * j); asm volatile("" ::: "memory"); } while (0)
#define P1A_PROC(i_) do { const int m = gw + (i_) * NGW, b = m >> 12; float s = 0.f; \
            _Pragma("unroll") for (int j = 0; j < 8; ++j) { const f32x4 q = v[(i_) % 3][j]; s += (q[0] * q[0] + q[1] * q[1]) + (q[2] * q[2] + q[3] * q[3]); } \
            const float rstd = 1.0f / sqrtf(wave_sum(s) * (1.0f / DM) + EPS); \
            v2u* o = (v2u*)(h1 + (size_t)m * DM) + F.lane; \
            _Pragma("unroll") for (int j = 0; j < 8; ++j) { const int k = 4 * F.lane + 256 * j; \
                const f32x4 rr = v[(i_) % 3][j] * rstd * *(const LAS f32x4*)(mulv + b * DM + k) + *(const LAS f32x4*)(shv + b * DM + k); v2u w; w.x = pk2(rr[0], rr[1]); w.y = pk2(rr[2], rr[3]); o[64 * j] = w; } \
            asm volatile("" ::: "memory"); } while (0)
        static_assert(MT == 8 * 256 * NWAVES, "8 rows per wave");
        P1A_LOAD(0); P1A_LOAD(1);
        P1A_LOAD(2); P1A_PROC(0); P1A_LOAD(3); P1A_PROC(1); P1A_LOAD(4); P1A_PROC(2); P1A_LOAD(5); P1A_PROC(3); P1A_LOAD(6); P1A_PROC(4); P1A_LOAD(7); P1A_PROC(5); P1A_PROC(6); P1A_PROC(7);
        __syncthreads();
#undef P1A_LOAD
#undef P1A_PROC
    }
    };
    auto part_bc = [&]() {
    {
        float* gm = (float*)(F.ws + WS_GMUL2); const float* gf = F.in[21];
        for (int i = F.vcu * NTHR + F.tid; i < NB * DM; i += F.G * NTHR) { const int b = i >> 11, k = i & 2047; gm[i] = gf[k] * (1.0f + mod[b * NMODW + 4 * DM + k]); }
    }
    };
    if (F.vcu & 1) { part_bc(); part_a(); } else { part_a(); part_bc(); }
}

typedef f32x2 cf;
__device__ __forceinline__ cf cmul(cf a, cf b) {
    cf t, r;
    asm("v_pk_mul_f32 %0, %2, %3 op_sel:[0,0] op_sel_hi:[0,1]\n\tv_pk_fma_f32 %1, %2, %3, %0 op_sel:[1,1,0] op_sel_hi:[1,0,1] neg_lo:[1,0,0]" : "=&v"(t), "=v"(r) : "v"(a), "v"(b));
    return r;
}
__device__ __forceinline__ cf cmulc(cf a, cf b) {
    cf t, r;
    asm("v_pk_mul_f32 %0, %2, %3 op_sel:[0,0] op_sel_hi:[0,1] neg_hi:[0,1]\n\tv_pk_fma_f32 %1, %2, %3, %0 op_sel:[1,1,0] op_sel_hi:[1,0,1]" : "=&v"(t), "=v"(r) : "v"(a), "v"(b));
    return r;
}
__device__ __forceinline__ cf cmul2(cf a, cf b, cf c) {
    cf t, r;
    asm("v_pk_mul_f32 %0, %2, %3 op_sel:[0,0] op_sel_hi:[0,1]\n\tv_pk_fma_f32 %1, %2, %3, %0 op_sel:[1,1,0] op_sel_hi:[1,0,1] neg_lo:[1,0,0]\n\t"
        "v_pk_mul_f32 %0, %1, %4 op_sel:[0,0] op_sel_hi:[0,1]\n\tv_pk_fma_f32 %1, %1, %4, %0 op_sel:[1,1,0] op_sel_hi:[1,0,1] neg_lo:[1,0,0]" : "=&v"(t), "=&v"(r) : "v"(a), "v"(b), "v"(c));
    return r;
}
__device__ __forceinline__ cf cmulc2(cf a, cf b, cf c) {
    cf t, r;
    asm("v_pk_mul_f32 %0, %2, %3 op_sel:[0,0] op_sel_hi:[0,1] neg_hi:[0,1]\n\tv_pk_fma_f32 %1, %2, %3, %0 op_sel:[1,1,0] op_sel_hi:[1,0,1]\n\t"
        "v_pk_mul_f32 %0, %1, %4 op_sel:[0,0] op_sel_hi:[0,1] neg_hi:[0,1]\n\tv_pk_fma_f32 %1, %1, %4, %0 op_sel:[1,1,0] op_sel_hi:[1,0,1]" : "=&v"(t), "=&v"(r) : "v"(a), "v"(b), "v"(c));
    return r;
}
template <bool CONJ> __device__ __forceinline__ cf mulc16(cf d, int J) {
    if (J == 0) return d;
    if (J == 4) return CONJ ? (cf){-d.y, d.x} : (cf){d.y, -d.x};
    const float C1 = 0.92387953251128674f, S1 = 0.38268343236508977f, R = 0.70710678118654752f;
    const int K = J & 3;
    const float cr = (K == 1) ? C1 : (K == 2) ? R : S1, ci = (K == 1) ? S1 : (K == 2) ? R : C1;
    cf w, r;
    if (!CONJ) { if (J < 4) { w = (cf){cr, -ci}; r = (cf){ci, cr}; } else { w = (cf){-ci, -cr}; r = (cf){cr, -ci}; } }
    else       { if (J < 4) { w = (cf){cr, ci}; r = (cf){-ci, cr}; } else { w = (cf){-ci, cr}; r = (cf){-cr, -ci}; } }
    return __builtin_elementwise_fma(__builtin_shufflevector(d, d, 1, 1), r, __builtin_shufflevector(d, d, 0, 0) * w);
}
struct Tw { cf w, r; };
__device__ __forceinline__ Tw tw_fwd(cf w) { Tw t; t.w = w; t.r = (cf){-w.y, w.x}; return t; }
__device__ __forceinline__ Tw tw_inv(cf w) { Tw t; t.w = (cf){w.x, -w.y}; t.r = (cf){w.y, w.x}; return t; }
__device__ __forceinline__ cf cmt(cf d, const Tw& t) { return __builtin_elementwise_fma(__builtin_shufflevector(d, d, 1, 1), t.r, __builtin_shufflevector(d, d, 0, 0) * t.w); }
__device__ __forceinline__ cf cmt_rot_fwd(cf d, const Tw& t) { return __builtin_elementwise_fma(__builtin_shufflevector(d, d, 1, 1), t.w, -(__builtin_shufflevector(d, d, 0, 0) * t.r)); }
__device__ __forceinline__ cf cmt_rot_inv(cf d, const Tw& t) { return __builtin_elementwise_fma(__builtin_shufflevector(d, d, 0, 0), t.r, -(__builtin_shufflevector(d, d, 1, 1) * t.w)); }
template <bool CONJ> __device__ __forceinline__ Tw c16tw(int J) {
    const float C1 = 0.92387953251128674f, S1 = 0.38268343236508977f, R = 0.70710678118654752f;
    const float cr = (J == 1) ? C1 : (J == 2) ? R : S1, ci = (J == 1) ? S1 : (J == 2) ? R : C1;
    Tw t; if (!CONJ) { t.w = (cf){cr, -ci}; t.r = (cf){ci, cr}; } else { t.w = (cf){cr, ci}; t.r = (cf){-ci, cr}; }
    return t;
}
template <bool CONJ> __device__ __forceinline__ cf mulc16w_s1(cf d, int J) { return (J & 3) ? cmt(d, c16tw<CONJ>(J & 3)) : d; }
template <bool CONJ> __device__ __forceinline__ cf mulc16w_s2(cf e, int J, const Tw& tw) { return (J < 4) ? cmt(e, tw) : (CONJ ? cmt_rot_inv(e, tw) : cmt_rot_fwd(e, tw)); }
template <bool TW> __device__ __forceinline__ void dif16(cf (&x)[16], cf w1) {
    Tw t1, t2, t4, t8;
    if (TW) { t1 = tw_fwd(w1); const cf w2 = cmt(w1, t1); t2 = tw_fwd(w2); const cf w4 = cmt(w2, t2); t4 = tw_fwd(w4); t8 = tw_fwd(cmt(w4, t4)); }
    cf d[8];
#pragma unroll
    for (int j = 0; j < 8; ++j) { const cf u = x[j], v = x[j + 8]; x[j] = u + v; d[j] = u - v; }
#pragma unroll
    for (int j = 0; j < 8; ++j) d[j] = TW ? mulc16w_s1<false>(d[j], j) : mulc16<false>(d[j], j);
#pragma unroll
    for (int j = 0; j < 8; ++j) x[j + 8] = TW ? mulc16w_s2<false>(d[j], j, t1) : d[j];
#pragma unroll
    for (int q = 0; q < 8; ++q) { const int j = (q & 3) + 8 * (q >> 2); const cf u = x[j], v = x[j + 4]; x[j] = u + v; d[q] = u - v; }
#pragma unroll
    for (int q = 0; q < 8; ++q) d[q] = TW ? mulc16w_s1<false>(d[q], 2 * (q & 3)) : mulc16<false>(d[q], 2 * (q & 3));
#pragma unroll
    for (int q = 0; q < 8; ++q) { const int j = (q & 3) + 8 * (q >> 2); x[j + 4] = TW ? mulc16w_s2<false>(d[q], 2 * (q & 3), t2) : d[q]; }
#pragma unroll
    for (int q = 0; q < 8; ++q) { const int j = (q & 1) + 4 * (q >> 1); const cf u = x[j], v = x[j + 2]; x[j] = u + v; d[q] = u - v; }
#pragma unroll
    for (int q = 0; q < 8; ++q) { const int j = (q & 1) + 4 * (q >> 1); x[j + 2] = TW ? mulc16w_s2<false>(d[q], 4 * (q & 1), t4) : mulc16<false>(d[q], 4 * (q & 1)); }
#pragma unroll
    for (int q = 0; q < 8; ++q) { const int j = 2 * q; const cf u = x[j], v = x[j + 1]; x[j] = u + v; d[q] = u - v; }
#pragma unroll
    for (int q = 0; q < 8; ++q) x[2 * q + 1] = TW ? cmt(d[q], t8) : d[q];
}
template <bool TW> __device__ __forceinline__ void dit16(cf (&x)[16], cf w1) {
    Tw t1, t2, t4, t8;
    if (TW) { const Tw f1 = tw_fwd(w1); const cf w2 = cmt(w1, f1); const Tw f2 = tw_fwd(w2); const cf w4 = cmt(w2, f2); const Tw f4 = tw_fwd(w4); const cf w8 = cmt(w4, f4);
        t1 = tw_inv(w1); t2 = tw_inv(w2); t4 = tw_inv(w4); t8 = tw_inv(w8); }
    cf v[8];
#pragma unroll
    for (int q = 0; q < 8; ++q) v[q] = TW ? cmt(x[2 * q + 1], t8) : x[2 * q + 1];
#pragma unroll
    for (int q = 0; q < 8; ++q) { const int j = 2 * q; const cf u = x[j]; x[j] = u + v[q]; x[j + 1] = u - v[q]; }
#pragma unroll
    for (int q = 0; q < 8; ++q) { const int j = (q & 1) + 4 * (q >> 1); v[q] = TW ? mulc16w_s2<true>(x[j + 2], 4 * (q & 1), t4) : mulc16<true>(x[j + 2], 4 * (q & 1)); }
#pragma unroll
    for (int q = 0; q < 8; ++q) { const int j = (q & 1) + 4 * (q >> 1); const cf u = x[j]; x[j] = u + v[q]; x[j + 2] = u - v[q]; }
#pragma unroll
    for (int q = 0; q < 8; ++q) { const int j = (q & 3) + 8 * (q >> 2); v[q] = TW ? mulc16w_s1<true>(x[j + 4], 2 * (q & 3)) : mulc16<true>(x[j + 4], 2 * (q & 3)); }
#pragma unroll
    for (int q = 0; q < 8; ++q) { if (TW) v[q] = mulc16w_s2<true>(v[q], 2 * (q & 3), t2); }
#pragma unroll
    for (int q = 0; q < 8; ++q) { const int j = (q & 3) + 8 * (q >> 2); const cf u = x[j]; x[j] = u + v[q]; x[j + 4] = u - v[q]; }
#pragma unroll
    for (int j = 0; j < 8; ++j) v[j] = TW ? mulc16w_s1<true>(x[j + 8], j) : mulc16<true>(x[j + 8], j);
#pragma unroll
    for (int j = 0; j < 8; ++j) { if (TW) v[j] = mulc16w_s2<true>(v[j], j, t1); }
#pragma unroll
    for (int j = 0; j < 8; ++j) { const cf u = x[j]; x[j] = u + v[j]; x[j + 8] = u - v[j]; }
}
constexpr int FFT_BUF_BYTES = 9216 * 8;
template <bool INV> __device__ __forceinline__ void fft_pass_a(LAS cf* buf, cf w1, int tid) {
    const int hi = tid >> 8, lo = tid & 255; LAS cf* p = buf + hi * 4608 + lo + 2 * (lo >> 4);
    cf x[16];
#pragma unroll
    for (int j = 0; j < 16; ++j) x[j] = p[288 * j];
    if (INV) dit16<true>(x, w1); else dif16<true>(x, w1);
#pragma unroll
    for (int j = 0; j < 16; ++j) p[288 * j] = x[j];
}
template <bool INV> __device__ __forceinline__ void fft_pass_b(LAS cf* buf, cf w1, int tid) {
    const int blk = tid >> 4, lo = tid & 15; LAS cf* p = buf + blk * 288 + lo;
    cf x[16];
#pragma unroll
    for (int j = 0; j < 16; ++j) x[j] = p[18 * j];
    if (INV) dit16<true>(x, w1); else dif16<true>(x, w1);
#pragma unroll
    for (int j = 0; j < 16; ++j) p[18 * j] = x[j];
}
__device__ __forceinline__ void fft_load_c(const LAS cf* buf, int tid, cf (&x)[16]) {
    const LAS f32x4* p = (const LAS f32x4*)(buf + 18 * tid);
#pragma unroll
    for (int j = 0; j < 8; ++j) { const f32x4 v = p[j]; x[2 * j] = (cf){v[0], v[1]}; x[2 * j + 1] = (cf){v[2], v[3]}; }
}
__device__ __forceinline__ void fft_store_c(LAS cf* buf, int tid, const cf (&x)[16]) {
    LAS f32x4* p = (LAS f32x4*)(buf + 18 * tid);
#pragma unroll
    for (int j = 0; j < 8; ++j) p[j] = (f32x4){x[2 * j].x, x[2 * j].y, x[2 * j + 1].x, x[2 * j + 1].y};
}
struct HyRaw { v4u w; unsigned hl, hr; };
__device__ __forceinline__ void hy_load_raw(HyRaw& R, const bf16* row, int t0) { R.w = __builtin_nontemporal_load((const v4u*)(row + t0)); R.hl = row[t0 > 0 ? t0 - 1 : 0]; R.hr = row[t0 + 8 < SEQ ? t0 + 8 : SEQ - 1]; }
__device__ __forceinline__ void hy_conv8(const HyRaw& R, int t0, const float (&cw)[4], float (&o)[8]) {
    const v4u w = R.w; float u[10];
    u[0] = t0 > 0 ? bf2f((unsigned short)R.hl) : 0.f; u[9] = t0 + 8 < SEQ ? bf2f((unsigned short)R.hr) : 0.f;
    u[1] = bflo(w.x); u[2] = bfhi(w.x); u[3] = bflo(w.y); u[4] = bfhi(w.y); u[5] = bflo(w.z); u[6] = bfhi(w.z); u[7] = bflo(w.w); u[8] = bfhi(w.w);
#pragma unroll
    for (int e = 0; e < 8; ++e) o[e] = cw[0] * u[e] + cw[1] * u[e + 1] + cw[2] * u[e + 2] + cw[3];
}
__device__ __forceinline__ cf mulsmall(cf w, int e) {
    float c, s;
    switch (e) { case 0: return w; case 1: c = 0.99999970586f; s = 0.00076699032f; break; case 2: c = 0.99999882345f; s = 0.00153398019f; break; case 3: c = 0.99999735277f; s = 0.00230096915f; break;
                 case 4: c = 0.99999529381f; s = 0.00306795676f; break; case 5: c = 0.99999264657f; s = 0.00383494256f; break; case 6: c = 0.99998941108f; s = 0.00460192612f; break; default: c = 0.99998558732f; s = 0.00536890696f; break; }
    Tw t; t.w = (cf){c, -s}; t.r = (cf){s, c};
    return cmt(w, t);
}
__device__ __forceinline__ void hyena_unit(Frame& F, int c) {
    LAS cf* buf0 = (LAS cf*)F.lds; LAS cf* buf1 = (LAS cf*)(F.lds + FFT_BUF_BYTES);
    const LAS cf* T1 = (const LAS cf*)(F.lds + 2 * FFT_BUF_BYTES); const LAS cf* T8 = T1 + 512;
    const int tid = F.tid, t0 = tid * 8;
    const float* Gt = (const float*)(F.ws + WS_GT) + (size_t)c * 8192;
    const bf16* hyT = (const bf16*)(F.ws + WS_VTHY); bf16* hyo = (bf16*)(F.ws + WS_HYOT);
    const float* sw = F.in[7]; const float* sb = F.in[8];
    const bf16* rx0 = hyT + (size_t)(1024 + c) * MT; const bf16* rx1 = hyT + (size_t)(2048 + c) * MT; const bf16* rv = hyT + (size_t)(3072 + c) * MT;
    HyRaw r1[4], r2[4];
#pragma unroll
    for (int b = 0; b < 4; ++b) { hy_load_raw(r1[b], rx1 + b * SEQ, t0); hy_load_raw(r2[b], rv + b * SEQ, t0); }
    const cf wa = T1[2 * (tid & 255)], wb = T8[4 * (tid & 15)];
#pragma unroll
    for (int e = 0; e < 8; ++e) { const int t = tid + 512 * e; const float g0 = __builtin_nontemporal_load(Gt + t), g1 = t ? __builtin_nontemporal_load(Gt + 8192 - t) : 0.f; const cf w = mulc16<false>(T1[tid], e); const float d = g0 - g1;
        LAS cf* p = buf0 + t + 2 * (t >> 4); p[0] = (cf){g0 + g1, 0.f}; p[4608] = (cf){d * w.x, d * w.y}; }
    __syncthreads();
    fft_pass_a<false>(buf0, wa, tid); __syncthreads();
    fft_pass_b<false>(buf0, wb, tid); __syncthreads();
    cf kf[16];
    fft_load_c(buf0, tid, kf); dif16<false>(kf, (cf){1.f, 0.f});
#pragma unroll
    for (int j = 0; j < 16; ++j) kf[j] = kf[j] * (1.0f / 8192.0f);
    __syncthreads();
    const float wx0[4] = {sw[c], sw[3072 + c], sw[6144 + c], sb[c]};
    const float wx1[4] = {sw[1024 + c], sw[3072 + 1024 + c], sw[6144 + 1024 + c], sb[1024 + c]};
    const float wv[4] = {sw[2048 + c], sw[3072 + 2048 + c], sw[6144 + 2048 + c], sb[2048 + c]};
    const float dbias = F.in[17][c];
    const int poff = t0 + 2 * (tid >> 1);
    float vv[4][8];
#pragma unroll
    for (int b = 0; b < 4; ++b) { float a[8], v[8]; hy_conv8(r1[b], t0, wx1, a); hy_conv8(r2[b], t0, wv, v);
#pragma unroll
        for (int e = 0; e < 8; ++e) vv[b][e] = a[e] * v[e]; }
#pragma unroll
    for (int e = 0; e < 8; ++e) { const Tw tw = tw_fwd(mulsmall(T8[tid], e)); const cf x0 = (cf){vv[0][e], vv[1][e]}, x1 = (cf){vv[2][e], vv[3][e]};
        buf0[poff + e] = x0; buf0[poff + 4608 + e] = cmt(x0, tw); buf1[poff + e] = x1; buf1[poff + 4608 + e] = cmt(x1, tw); }
    __syncthreads();
    fft_pass_a<false>(buf0, wa, tid); __builtin_amdgcn_sched_barrier(0); fft_pass_a<false>(buf1, wa, tid); __syncthreads();
    fft_pass_b<false>(buf0, wb, tid); __builtin_amdgcn_sched_barrier(0); fft_pass_b<false>(buf1, wb, tid); __syncthreads();
#pragma unroll
    for (int p = 0; p < 2; ++p) { LAS cf* buf = p ? buf1 : buf0; cf x[16]; fft_load_c(buf, tid, x); dif16<false>(x, (cf){1.f, 0.f});
#pragma unroll
        for (int j = 0; j < 16; ++j) x[j] = cmul(x[j], kf[j]);
        dit16<false>(x, (cf){1.f, 0.f}); fft_store_c(buf, tid, x); }
    __syncthreads();
    fft_pass_b<true>(buf0, wb, tid); __builtin_amdgcn_sched_barrier(0); fft_pass_b<true>(buf1, wb, tid); __syncthreads();
    HyRaw r0[4];
#pragma unroll
    for (int b = 0; b < 4; ++b) hy_load_raw(r0[b], rx0 + b * SEQ, t0);
    fft_pass_a<true>(buf0, wa, tid); __builtin_amdgcn_sched_barrier(0); fft_pass_a<true>(buf1, wa, tid); __syncthreads();
#pragma unroll
    for (int p = 0; p < 2; ++p) { const LAS cf* buf = p ? buf1 : buf0; cf y[8];
#pragma unroll
        for (int e = 0; e < 8; ++e) y[e] = buf[poff + e] + cmt(buf[poff + 4608 + e], tw_inv(mulsmall(T8[tid], e)));
#pragma unroll
        for (int bb = 0; bb < 2; ++bb) { const int b = 2 * p + bb; float x0[8], o[8];
            hy_conv8(r0[b], t0, wx0, x0);
#pragma unroll
            for (int e = 0; e < 8; ++e) o[e] = ((bb == 0 ? y[e].x : y[e].y) + vv[b][e] * dbias) * x0[e];
            v4u w; w.x = pk2(o[0], o[1]); w.y = pk2(o[2], o[3]); w.z = pk2(o[4], o[5]); w.w = pk2(o[6], o[7]);
            *(v4u*)(hyo + (size_t)c * MT + b * SEQ + t0) = w; } }
    __syncthreads();
}

#define NA_MFMA(a, b, c) __builtin_amdgcn_mfma_f32_32x32x16_bf16((a), (b), (c), 0, 0, 0)
__device__ __forceinline__ unsigned cvtpk(float lo, float hi) { typedef __bf16 bf2_t __attribute__((ext_vector_type(2))); const f32x2 v = {lo, hi}; const bf2_t b = __builtin_convertvector(v, bf2_t); return __builtin_bit_cast(unsigned, b); }
__device__ __forceinline__ void xhalf(float x, float& a, float& b) { const unsigned u = __builtin_bit_cast(unsigned, x); const auto r = __builtin_amdgcn_permlane32_swap(u, u, false, false); a = __builtin_bit_cast(float, (unsigned)r[0]); b = __builtin_bit_cast(float, (unsigned)r[1]); }
__device__ __forceinline__ void na_tile(const bf16x8 (&kf)[4], const bf16x8 (&vf)[2][2], const LAS unsigned char* qimg, f32x16 (&o)[2][2], float (&mrun)[2], float (&lrun)[2],
                                        const LAS float* brow, int kt, int hh8, const int (&cq)[2], const int (&cs)[2]) {
#pragma unroll
    for (int qt = 0; qt < 2; ++qt) {
        f32x16 s; bf16x8 qf[4];
#pragma unroll
        for (int ds = 0; ds < 4; ++ds) qf[ds] = *(const LAS bf16x8*)(qimg + (qt * 4 + ds) * 1024);
        const int e0 = (qt != kt) ? 8 * (1 - kt) : 0, e1 = (qt != kt) ? e0 + 8 : 16;
        const int koff = 32 * kt + hh8;
        const LAS float* bp = brow + (koff - cq[qt] + 15);
        float bv[16];
#pragma unroll
        for (int e = 0; e < 16; ++e) if (e >= e0 && e < e1) bv[e] = bp[(e & 3) + 4 * ((e >> 2) & 1) + 16 * (e >> 3)];
        asm volatile("" ::: "memory");
        const int vlo = koff - cs[qt];
#pragma unroll
        for (int e = 0; e < 16; ++e) { const bool valid = (unsigned)(vlo + ((e & 3) + 4 * ((e >> 2) & 1) + 16 * (e >> 3))) < 16u;
            s[e] = (e >= e0 && e < e1) ? (valid ? bv[e] : -INFINITY) : 0.f; }
#pragma unroll
        for (int ds = 0; ds < 4; ++ds) s = NA_MFMA(kf[ds], qf[ds], s);
        float mx = -INFINITY;
#pragma unroll
        for (int e = 0; e < 16; ++e) if (e >= e0 && e < e1) mx = fmaxf(mx, s[e]);
        { float a_, b_; xhalf(mx, a_, b_); mx = fmaxf(a_, b_); }
        if (__builtin_amdgcn_ballot_w64(mx > mrun[qt] + 8.0f) != 0ull) {
            const float mnew = fmaxf(mrun[qt], mx), ms = (mnew == -INFINITY) ? 0.f : mnew;
            const float alpha = __builtin_amdgcn_exp2f(mrun[qt] - ms);
            lrun[qt] *= alpha; mrun[qt] = mnew;
#pragma unroll
            for (int dt = 0; dt < 2; ++dt)
#pragma unroll
                for (int e = 0; e < 16; ++e) o[dt][qt][e] *= alpha;
        }
        const float msafe = (mrun[qt] == -INFINITY) ? 0.f : mrun[qt];
        f32x2 sum2 = {0.f, 0.f};
#pragma unroll
        for (int e = 0; e < 16; e += 2) if (e >= e0 && e < e1) { const f32x2 d = (f32x2){s[e], s[e + 1]} - (f32x2){msafe, msafe};
            const f32x2 pq = {__builtin_amdgcn_exp2f(d.x), __builtin_amdgcn_exp2f(d.y)}; s[e] = pq.x; s[e + 1] = pq.y; sum2 = sum2 + pq; }
        float sum = sum2.x + sum2.y;
        { float a_, b_; xhalf(sum, a_, b_); sum = a_ + b_; }
        lrun[qt] += sum;
        bf16x8 pf[2];
#pragma unroll
        for (int s2 = 0; s2 < 2; ++s2) if (8 * s2 >= e0 && 8 * s2 < e1) { v4u p; p.x = cvtpk(s[8 * s2 + 0], s[8 * s2 + 1]); p.y = cvtpk(s[8 * s2 + 2], s[8 * s2 + 3]); p.z = cvtpk(s[8 * s2 + 4], s[8 * s2 + 5]); p.w = cvtpk(s[8 * s2 + 6], s[8 * s2 + 7]);
            pf[s2] = __builtin_bit_cast(bf16x8, p); }
#pragma unroll
        for (int dt = 0; dt < 2; ++dt)
#pragma unroll
            for (int s2 = 0; s2 < 2; ++s2) if (8 * s2 >= e0 && 8 * s2 < e1) o[dt][qt] = NA_MFMA(vf[dt][s2], pf[s2], o[dt][qt]);
    }
}
__device__ __forceinline__ void na_load_k(bf16x8 (&kf)[4], const bf16* p) {
#pragma unroll
    for (int ds = 0; ds < 4; ++ds) kf[ds] = *(const bf16x8*)(p + 512 * ds);
}
__device__ __forceinline__ void na_load_v(bf16x8 (&vf)[2][2], const bf16* p) {
#pragma unroll
    for (int dt = 0; dt < 2; ++dt)
#pragma unroll
        for (int s2 = 0; s2 < 2; ++s2) vf[dt][s2] = *(const bf16x8*)(p + 512 * (dt * 2 + s2));
}
__device__ __forceinline__ void na_unit(Frame& F, int unit, LAS float* tab) {
    const int lane = F.lane, c32 = lane & 31, hh = lane >> 5;
    const int r = unit & 63, h = (unit >> 6) & 15, b = unit >> 10;
    const bf16* qkf = (const bf16*)(F.ws + WS_QK); const bf16* vfr = (const bf16*)(F.ws + WS_VTHY); bf16* nao = (bf16*)(F.ws + WS_NAOUT);
    const float* rpb = F.in[6] + h * 465;
    const int rs = min(max(r - 4, 0), 56);
    const size_t mq = (size_t)b * SEQ + r * 64;
    const bf16* qbase = qkf + (((size_t)(b * 16 + h) * 64 + r) * 8) * 512 + lane * 8;
    const bf16* kbase = qkf + (((size_t)((4 + b) * 16 + h) * 64 + rs) * 8) * 512 + lane * 8;
    const bf16* vbase = vfr + (((size_t)(b * 16 + h) * 64 + rs) * 8) * 512 + lane * 8;
    bf16x8 kfA[4], kfB[4], vf[2][2];
    na_load_k(kfA, kbase);
    for (int i = lane; i < 465; i += 64) tab[i] = rpb[i] * 1.4426950408889634f;
    LAS unsigned char* qimg = (LAS unsigned char*)tab + 2048 + lane * 16;
#pragma unroll
    for (int f = 0; f < 8; ++f) *(LAS v4u*)(qimg + f * 1024) = *(const v4u*)(qbase + 512 * f);
    f32x16 o[2][2];
#pragma unroll
    for (int dt = 0; dt < 2; ++dt)
#pragma unroll
        for (int qt = 0; qt < 2; ++qt)
#pragma unroll
            for (int e = 0; e < 16; ++e) o[dt][qt][e] = 0.f;
    float mrun[2] = {-INFINITY, -INFINITY}, lrun[2] = {0.f, 0.f};
    int cq[2], cs[2]; int hh8 = 8 * hh;
#pragma unroll
    for (int qt = 0; qt < 2; ++qt) { cq[qt] = 32 * qt + c32; cs[qt] = min(max(cq[qt] - 8, 0), 48); }
#pragma unroll 1
    for (int i = 0; i < 8; ++i) {
        const LAS float* brow = tab + (rs + i - r + 7) * 31;
        na_load_k(kfB, kbase + (size_t)(8 * i + 4) * 512);
        na_load_v(vf, vbase + (size_t)(8 * i) * 512);
        __builtin_amdgcn_sched_barrier(0);
        na_tile(kfA, vf, qimg, o, mrun, lrun, brow, 0, hh8, cq, cs);
        na_load_k(kfA, kbase + (size_t)(8 * (i < 7 ? i + 1 : i)) * 512);
        na_load_v(vf, vbase + (size_t)(8 * i + 4) * 512);
        __builtin_amdgcn_sched_barrier(0);
        na_tile(kfB, vf, qimg, o, mrun, lrun, brow, 1, hh8, cq, cs);
    }
    LAS unsigned char* oimg = (LAS unsigned char*)tab + 2048;
#pragma unroll
    for (int qt = 0; qt < 2; ++qt) { const float inv = 1.0f / lrun[qt]; const int q = 32 * qt + c32;
#pragma unroll
        for (int dt = 0; dt < 2; ++dt)
#pragma unroll
            for (int g = 0; g < 4; ++g) { v2u w; w.x = cvtpk(o[dt][qt][4 * g] * inv, o[dt][qt][4 * g + 1] * inv); w.y = cvtpk(o[dt][qt][4 * g + 2] * inv, o[dt][qt][4 * g + 3] * inv);
                const int d = 32 * dt + 8 * g + 4 * hh;
                *(LAS v2u*)(oimg + q * 128 + ((((d >> 3) ^ (q & 7)) << 4) | ((d & 4) << 1))) = w; } }
    asm volatile("s_waitcnt lgkmcnt(0)" ::: "memory");
#pragma unroll
    for (int it = 0; it < 8; ++it) { const int q = it * 8 + (lane >> 3), ch = lane & 7;
        const v4u w = *(const LAS v4u*)(oimg + q * 128 + ((ch ^ (q & 7)) << 4));
        *(v4u*)(nao + (mq + q) * DNA + h * 64 + 8 * ch) = w; }
    asm volatile("s_waitcnt lgkmcnt(0)" ::: "memory");
}

__device__ __forceinline__ void p3_phase(Frame& F) {
    {
        const f32x2* twg = (const f32x2*)(F.ws + WS_TW); LAS f32x2* T1 = (LAS f32x2*)(F.lds + 2 * FFT_BUF_BYTES);
        T1[F.tid] = twg[F.tid]; T1[512 + F.tid] = twg[8 * F.tid];
        __syncthreads();
    }
#ifndef NO_HYENA
    for (int rep = 0; rep < DUPN(10); ++rep)
    for (int c = F.vcu; c < DHY; c += F.G) hyena_unit(F, c);
#endif
#ifndef NO_NA
    LAS float* tab = (LAS float*)(F.lds + F.wave * 10240);
    __syncthreads();
    for (int rep = 0; rep < DUPN(11); ++rep)
    for (int u8 = F.vcu; u8 < (NB * NHEAD * 64) / 8; u8 += F.G) na_unit(F, u8 * 8 + F.wave, tab);
#endif
}

__device__ __forceinline__ void p4_phase(Frame& F) {
    constexpr int PITCH = 1032;
    LAS bf16* tile = (LAS bf16*)F.lds;
    const bf16* hyo = (const bf16*)(F.ws + WS_HYOT); const bf16* nao = (const bf16*)(F.ws + WS_NAOUT); bf16* mg = (bf16*)(F.ws + WS_H1);
    for (int tb = F.vcu; tb < MT / 64; tb += F.G) {
        const int m0 = tb * 64;
#pragma unroll 4
        for (int it = 0; it < 16; ++it) { const int c = it * 64 + (F.tid >> 3), ch = F.tid & 7;
            const v4u w = __builtin_nontemporal_load((const v4u*)(hyo + (size_t)c * MT + m0 + ch * 8));
            LAS bf16* d = tile + (ch * 8) * PITCH + (c ^ (ch << 4));
            d[0] = (bf16)(w.x & 0xffff); d[PITCH] = (bf16)(w.x >> 16); d[2 * PITCH] = (bf16)(w.y & 0xffff); d[3 * PITCH] = (bf16)(w.y >> 16);
            d[4 * PITCH] = (bf16)(w.z & 0xffff); d[5 * PITCH] = (bf16)(w.z >> 16); d[6 * PITCH] = (bf16)(w.w & 0xffff); d[7 * PITCH] = (bf16)(w.w >> 16); }
        __syncthreads();
        for (int tk = F.wave * 8; tk < F.wave * 8 + 8; ++tk) {
            const size_t m = (size_t)m0 + tk;
            {
                const int gsw = (F.lane ^ (tk >> 3)) * 16;
                const v4u w0 = *(const LAS v4u*)(tile + tk * PITCH + gsw), w1 = *(const LAS v4u*)(tile + tk * PITCH + gsw + 8);
                const unsigned ww[8] = {w0.x, w0.y, w0.z, w0.w, w1.x, w1.y, w1.z, w1.w}; float f[16]; float s = 0.f;
#pragma unroll
                for (int e = 0; e < 8; ++e) { f[2 * e] = bflo(ww[e]); f[2 * e + 1] = bfhi(ww[e]); s += f[2 * e] * f[2 * e] + f[2 * e + 1] * f[2 * e + 1]; }
                const float rstd = 1.0f / sqrtf(wave_sum(s) * (1.0f / DHY) + EPS);
                v4u o0, o1; o0.x = pk2(f[0] * rstd, f[1] * rstd); o0.y = pk2(f[2] * rstd, f[3] * rstd); o0.z = pk2(f[4] * rstd, f[5] * rstd); o0.w = pk2(f[6] * rstd, f[7] * rstd);
                o1.x = pk2(f[8] * rstd, f[9] * rstd); o1.y = pk2(f[10] * rstd, f[11] * rstd); o1.z = pk2(f[12] * rstd, f[13] * rstd); o1.w = pk2(f[14] * rstd, f[15] * rstd);
                v4u* dst = (v4u*)(mg + m * DM + DNA + F.lane * 16); dst[0] = o0; dst[1] = o1;
            }
            {
                const v4u* src = (const v4u*)(nao + m * DNA + F.lane * 16); const v4u w0 = __builtin_nontemporal_load(src), w1 = __builtin_nontemporal_load(src + 1);
                const unsigned ww[8] = {w0.x, w0.y, w0.z, w0.w, w1.x, w1.y, w1.z, w1.w}; float f[16]; float s = 0.f;
#pragma unroll
                for (int e = 0; e < 8; ++e) { f[2 * e] = bflo(ww[e]); f[2 * e + 1] = bfhi(ww[e]); s += f[2 * e] * f[2 * e] + f[2 * e + 1] * f[2 * e + 1]; }
                const float rstd = 1.0f / sqrtf(wave_sum(s) * (1.0f / DNA) + EPS);
                v4u o0, o1; o0.x = pk2(f[0] * rstd, f[1] * rstd); o0.y = pk2(f[2] * rstd, f[3] * rstd); o0.z = pk2(f[4] * rstd, f[5] * rstd); o0.w = pk2(f[6] * rstd, f[7] * rstd);
                o1.x = pk2(f[8] * rstd, f[9] * rstd); o1.y = pk2(f[10] * rstd, f[11] * rstd); o1.z = pk2(f[12] * rstd, f[13] * rstd); o1.w = pk2(f[14] * rstd, f[15] * rstd);
                v4u* dst = (v4u*)(mg + m * DM + F.lane * 16); dst[0] = o0; dst[1] = o1;
            }
        }
        __syncthreads();
    }
}

__device__ __forceinline__ void p_fixup_panel(Frame& F, int pm) {
    const float* eA = (const float*)(F.ws + WS_EDGEA); const float* eB = (const float*)(F.ws + WS_EDGEB); bf16* gated = (bf16*)(F.ws + WS_GATED);
    const float* cw = F.in[23]; const float* cb = F.in[24];
    for (int i = F.tid; i < 2 * DFF; i += NTHR) {
        const int bot = i >= DFF ? 1 : 0, j = i - bot * DFF;
        if (!bot && (pm & 15) == 0) continue;
        if (bot && (pm & 15) == 15) continue;
        float pv, cv, nv, bv; int row;
        if (!bot) { pv = eA[((size_t)(pm - 1) * 4 + 3) * DFF + j]; cv = eA[((size_t)pm * 4 + 0) * DFF + j]; nv = eA[((size_t)pm * 4 + 1) * DFF + j]; bv = eB[((size_t)pm * 2 + 0) * DFF + j]; row = pm * 256; }
        else { pv = eA[((size_t)pm * 4 + 2) * DFF + j]; cv = eA[((size_t)pm * 4 + 3) * DFF + j]; nv = eA[((size_t)(pm + 1) * 4 + 0) * DFF + j]; bv = eB[((size_t)pm * 2 + 1) * DFF + j]; row = pm * 256 + 255; }
        const float a = cw[j] * pv + cw[DFF + j] * cv + cw[2 * DFF + j] * nv + cb[j];
        const float g = 0.5f * a * (1.0f + erff(a * 0.70710678118654752f));
        gated[(size_t)row * DFF + j] = (bf16)f2bf(g * bv);
    }
}
__device__ __forceinline__ void p_final(Frame& F) {
    const int gw = F.vcu * NWAVES + F.wave, NGW = F.G * NWAVES; const float* g = F.in[26]; const bf16* x2 = (const bf16*)(F.ws + WS_H1);
    for (int m = gw; m < MT; m += NGW) {
        const v4u* xr = (const v4u*)(x2 + (size_t)m * DM) + F.lane; f32x4* orow = (f32x4*)(F.out + (size_t)m * DM); v4u w[4]; float s = 0.f;
#pragma unroll
        for (int j = 0; j < 4; ++j) w[j] = __builtin_nontemporal_load(xr + 64 * j);
        float f[4][8];
#pragma unroll
        for (int j = 0; j < 4; ++j) { f[j][0] = bflo(w[j].x); f[j][1] = bfhi(w[j].x); f[j][2] = bflo(w[j].y); f[j][3] = bfhi(w[j].y); f[j][4] = bflo(w[j].z); f[j][5] = bfhi(w[j].z); f[j][6] = bflo(w[j].w); f[j][7] = bfhi(w[j].w);
#pragma unroll
            for (int e = 0; e < 8; ++e) s += f[j][e] * f[j][e]; }
        const float rstd = 1.0f / sqrtf(wave_sum(s) * (1.0f / DM) + EPS);
#pragma unroll
        for (int j = 0; j < 4; ++j) { const int k = 8 * F.lane + 512 * j; const f32x4 g0 = *(const f32x4*)(g + k), g1 = *(const f32x4*)(g + k + 4);
            __builtin_nontemporal_store((f32x4){f[j][0], f[j][1], f[j][2], f[j][3]} * rstd * g0, orow + (k >> 2)); __builtin_nontemporal_store((f32x4){f[j][4], f[j][5], f[j][6], f[j][7]} * rstd * g1, orow + (k >> 2) + 1); }
    }
}

#define XB_TMO      128
#define XB_XCNT(j)  (256  + 64 * (j))
#define XB_XSUB(j)  (1280 + 64 * (j))
#define XB_XGEN(j)  (2304 + 64 * (j))
#define XB_TOP      3328
#define XB_TOPGEN   3392
#define XCD_BAR_WORDS 3456
#define XB_SPIN_CAP (1u << 18)

__device__ __forceinline__ unsigned xb_ld(unsigned* p)              { return __hip_atomic_load(p, __ATOMIC_RELAXED, __HIP_MEMORY_SCOPE_AGENT); }
__device__ __forceinline__ unsigned xb_add(unsigned* p, unsigned v) { return __hip_atomic_fetch_add(p, v, __ATOMIC_RELAXED, __HIP_MEMORY_SCOPE_AGENT); }
__device__ __forceinline__ unsigned xb_xcc_id() { return (unsigned)__builtin_amdgcn_s_getreg((3 << 11) | 20) & 0xFu; }
#define XB_SPIN(cond, bar) do { unsigned _sp = 0; while (cond) { __builtin_amdgcn_s_sleep(1); \
    if ((++_sp & 255u) == 0u) { if (xb_ld(&(bar)[XB_TMO])) break; if (_sp > XB_SPIN_CAP) { atomicAdd(&(bar)[XB_TMO], 1u); break; } } } } while (0)

struct XcdBarrier {
    unsigned* bar; unsigned x;
    volatile LAS unsigned* st;
};

__device__ __forceinline__ XcdBarrier xcd_barrier_post(unsigned* bar, volatile LAS unsigned* st) {
    XcdBarrier b; b.bar = bar; b.x = xb_xcc_id(); b.st = st;
    if (threadIdx.x == 0) (void)xb_add(&bar[XB_XCNT(b.x)], 1u);
    return b;
}
__device__ __forceinline__ void xcd_barrier_complete(unsigned* bar, unsigned x, unsigned& nloc, unsigned& nx) {
    const unsigned G = gridDim.x * gridDim.y * gridDim.z;
    unsigned sum, cnt, mine, sp = 0u;
    for (;;) {
        sum = 0u; cnt = 0u; mine = 0u;
#pragma unroll
        for (unsigned j = 0; j < 16; ++j) { const unsigned c = xb_ld(&bar[XB_XCNT(j)]); sum += c; cnt += (c > 0u) ? 1u : 0u; mine = (j == x) ? c : mine; }
        if (sum == G) break;
        __builtin_amdgcn_s_sleep(1);
        if ((++sp & 255u) == 0u) { if (xb_ld(&bar[XB_TMO])) break; if (sp > XB_SPIN_CAP) { atomicAdd(&bar[XB_TMO], 1u); break; } }
    }
    nloc = mine > 0u ? mine : 1u; nx = cnt > 0u ? cnt : 1u;
}

__device__ __forceinline__ void xcd_barrier(const XcdBarrier& b) {
    asm volatile("s_waitcnt vmcnt(0)" ::: "memory");
    __syncthreads();
    if (threadIdx.x == 0) {
        unsigned* bar = b.bar;
        __builtin_amdgcn_s_waitcnt(0);
        unsigned nloc = b.st[0], nx = b.st[1];
        if (nloc == 0u) { xcd_barrier_complete(bar, b.x, nloc, nx); b.st[0] = nloc; b.st[1] = nx; }
        const unsigned old = xb_add(&bar[XB_XSUB(b.x)], 1u);
        const unsigned gen = old / nloc;
        if (old + 1u == (gen + 1u) * nloc) {
            __builtin_amdgcn_fence(__ATOMIC_RELEASE, "agent");
            asm volatile("s_waitcnt vmcnt(0)" ::: "memory");
            const unsigned og = xb_add(&bar[XB_TOP], 1u);
            const unsigned tg = og / nx;
            if (og + 1u == (tg + 1u) * nx) xb_add(&bar[XB_TOPGEN], 1u);
            else XB_SPIN(xb_ld(&bar[XB_TOPGEN]) == tg, bar);
            __builtin_amdgcn_fence(__ATOMIC_ACQUIRE, "agent");
            xb_add(&bar[XB_XGEN(b.x)], 1u);
            asm volatile("s_waitcnt vmcnt(0)" ::: "memory");
        } else {
            XB_SPIN(xb_ld(&bar[XB_XGEN(b.x)]) == gen, bar);
            __builtin_amdgcn_fence(__ATOMIC_ACQUIRE, "agent");
            asm volatile("s_waitcnt vmcnt(0)" ::: "memory");
        }
    }
    __syncthreads();
}


struct Args { const float* in[27]; float* out; unsigned char* ws; int ph_lo, ph_hi; };
__global__ void __launch_bounds__(NTHR, 2) fwd_megakernel(Args args) {
    extern __shared__ __attribute__((aligned(16))) unsigned char lds[];
    cg::grid_group grid = cg::this_grid();
    Frame F;
    F.lds = (LAS unsigned char*)lds;
    F.tid = threadIdx.x; F.lane = F.tid & 63; F.wave = __builtin_amdgcn_readfirstlane(F.tid >> 6);
    F.G = gridDim.x; { const int bx = blockIdx.x; F.vcu = (F.G % 8 == 0) ? (bx % 8) * (F.G / 8) + bx / 8 : bx; }
    F.in = (const float* const __attribute__((address_space(4)))*)__builtin_amdgcn_kernarg_segment_ptr();
    F.out = args.out; F.ws = args.ws;
    const int lo = args.ph_lo, hi = args.ph_hi;
#ifndef PHASE_MASK
#define PHASE_MASK 0x3ff
#endif
#define IN(k) (((PHASE_MASK >> (k)) & 1) && lo <= (k) && (k) < hi)
    const bool one_launch = (lo == 0 && hi == N_PHASES);
    volatile LAS unsigned* barst = (volatile LAS unsigned*)(F.lds + BARST_OFF);
    if (F.tid < 2) barst[F.tid] = 0u;
    __syncthreads();
    XcdBarrier bar; bar.bar = (unsigned*)(args.ws + WS_BAR); bar.x = 0; bar.st = barst;
    if (one_launch) bar = xcd_barrier_post((unsigned*)(args.ws + WS_BAR), barst);
#define SEAM(k) do { if (IN(k) && IN((k) + 1)) { if (!one_launch) grid.sync(); else xcd_barrier(bar); } } while (0)
    unsigned char* ws = args.ws;
#ifdef CLK_PROBE
#define STAMP(i) do { if (blockIdx.x == 0 && F.tid == 0) { unsigned long long* tp = (unsigned long long*)(args.ws + WS_CTL + 768 * 1024); tp[2 * (i)] = __builtin_amdgcn_s_memtime(); tp[2 * (i) + 1] = __builtin_amdgcn_s_memrealtime(); tp[64 + (i)] = __hip_atomic_load(&pg8::pg8_probe_epi, __ATOMIC_RELAXED, __HIP_MEMORY_SCOPE_AGENT); } } while (0)
#else
#define STAMP(i) do { } while (0)
#endif
    STAMP(0);
    if (IN(0)) { p0_prologue(F); } SEAM(0);
    STAMP(1);
    if (IN(1)) { for (int rep = 0; rep < DUPN(1); ++rep) p1_phase(F); } SEAM(1);
    STAMP(2);
    if (IN(2)) { if (F.vcu & 1) { p_filters(F); p_convert_late(F); } }
    if (IN(2)) for (int rep = 0; rep < DUPN(2); ++rep) {
        {
            pg8::Gemm g{(const pg8::bf16_t*)(ws + WS_H1), (const pg8::bf16_t*)(ws + WS_WTIN), MT, 2048, DM}; pg8::StaticOrder S; S.init(MT, 2048, F.G, (int)blockIdx.x);
            pg8::EpiFragQK E{(pg8::bf16_t*)(ws + WS_QK), 0.125f * 1.4426950408889634f};
            pg8::gemm_phase<pg8::EpiFragQK, pg8::StaticOrder, PG8_ALIGN, PG8_SP2>(F.lds, g, S, E);
        }
        {
            pg8::Gemm g{(const pg8::bf16_t*)(ws + WS_WTIN) + (size_t)2048 * DM, (const pg8::bf16_t*)(ws + WS_H1), 4096, MT, DM}; pg8::StaticOrder S; S.init(4096, MT, F.G, (int)blockIdx.x);
            pg8::EpiVHy E{(pg8::bf16_t*)(ws + WS_VTHY), MT};
            pg8::gemm_phase<pg8::EpiVHy, pg8::StaticOrder, PG8_ALIGN, PG8_SP2>(F.lds, g, S, E);
        }
    }
    if (IN(2)) { if (!(F.vcu & 1)) { p_filters(F); p_convert_late(F); } }
    SEAM(2);
    STAMP(3);
    if (IN(3)) { p3_phase(F); } SEAM(3);
    STAMP(4);
    if (IN(4)) { for (int rep = 0; rep < DUPN(4); ++rep) p4_phase(F); } SEAM(4);
    STAMP(5);
    if (IN(5)) {
        const float* mod = (const float*)(ws + WS_MOD);
        pg8::Gemm g{(const pg8::bf16_t*)(ws + WS_H1), (const pg8::bf16_t*)(ws + WS_WTOUT), MT, DM, DM}; pg8::StaticOrder S; S.init(MT, DM, F.G, (int)blockIdx.x);
        pg8::EpiRes1 E{F.in[0], (pg8::bf16_t*)F.out, (pg8::bf16_t*)(ws + WS_A2), mod + 2 * DM, NMODW, (const float*)(ws + WS_GMUL2), (float*)(ws + WS_SSQ1), DM, (PG8_LAS float*)(F.lds + XCH_OFF)};
        if (F.vcu & 1) p_biasu(F);
        pg8::gemm_phase<pg8::EpiRes1, pg8::StaticOrder, PG8_ALIGN, PG8_SP2>(F.lds, g, S, E);
        if (!(F.vcu & 1)) p_biasu(F);
    } SEAM(5);
    STAMP(6);
    if (IN(6)) for (int rep = 0; rep < DUPN(6); ++rep) {
        pg8::Gemm g{(const pg8::bf16_t*)(ws + WS_A2), (const pg8::bf16_t*)(ws + WS_WTUP), MT, 2 * DFF, DM}; pg8::StaticOrder S; S.init(MT, 2 * DFF, F.G, (int)blockIdx.x);
        pg8::EpiGlu E{(pg8::bf16_t*)(ws + WS_GATED), (const float*)(ws + WS_SSQ1), (const float*)(ws + WS_BIASU), F.in[23], F.in[24], (float*)(ws + WS_EDGEA), (float*)(ws + WS_EDGEB), (PG8_LAS float*)(F.lds + XCH_OFF), DFF};
        pg8::gemm_phase<pg8::EpiGlu, pg8::StaticOrder, true, PG8_SP2>(F.lds, g, S, E);
    } SEAM(6);
    STAMP(8);
    if (IN(8)) {
        const float* mod = (const float*)(ws + WS_MOD);
        pg8::Gemm g{(const pg8::bf16_t*)(ws + WS_GATED), (const pg8::bf16_t*)(ws + WS_WTDN), MT, DM, DFF}; pg8::StaticOrder S; S.init(MT, DM, F.G, (int)blockIdx.x);
        { pg8::Unit u; for (int i = 0; S.next(i, u); ++i) p_fixup_panel(F, u.pm); asm volatile("s_waitcnt vmcnt(0)" ::: "memory"); __syncthreads(); }
        pg8::EpiRes2 E{(const pg8::bf16_t*)F.out, (pg8::bf16_t*)(ws + WS_H1), mod + 5 * DM, NMODW, DM};
        pg8::gemm_phase<pg8::EpiRes2, pg8::StaticOrder, PG8_ALIGN, PG8_SP2>(F.lds, g, S, E);
    } SEAM(8);
    STAMP(9);
    if (IN(9)) { p_final(F); }
#ifdef CLK_PROBE
    STAMP(10); __syncthreads();
    if (blockIdx.x == 0 && F.tid == 0) { const volatile unsigned long long* tp = (const volatile unsigned long long*)(args.ws + WS_CTL + 768 * 1024);
        const double dc = (double)(tp[2 * CLK_B] - tp[2 * CLK_A]), dr = (double)(tp[2 * CLK_B + 1] - tp[2 * CLK_A + 1]);
        const double de = (double)(tp[64 + CLK_B] - tp[64 + CLK_A]);
        const double val = (CLK_PROBE == 1) ? dc / dr * 0.1 * 500.0 : (CLK_PROBE == 3) ? de * (1.0 / 500.0) : dr * 0.01;
        const unsigned long long t0 = __builtin_amdgcn_s_memrealtime(), wait = (unsigned long long)(val * 100.0);
        while (__builtin_amdgcn_s_memrealtime() - t0 < wait) __builtin_amdgcn_s_sleep(8); }
#endif
#undef IN
#undef SEAM
}

extern "C" void kernel_launch(void* const* d_in, const int* in_sizes, int n_in, void* d_out, int out_size, void* d_ws, size_t ws_size, hipStream_t stream) {
    static int grid = 0;
    if (grid == 0) {
        if (n_in != 27 || out_size != MT * DM || ws_size < WS_END) { fprintf(stderr, "kernel_launch: unexpected sizes n_in %d out %d ws %zu\n", n_in, out_size, ws_size); grid = -1; return; }
        int dev = 0, cus = 0, per_cu = 0;
        if (hipGetDevice(&dev) != hipSuccess || hipDeviceGetAttribute(&cus, hipDeviceAttributeMultiprocessorCount, dev) != hipSuccess) { grid = -1; return; }
        if (hipFuncSetAttribute((const void*)fwd_megakernel, hipFuncAttributeMaxDynamicSharedMemorySize, LDS_BYTES) != hipSuccess) { fprintf(stderr, "kernel_launch: hipFuncSetAttribute failed\n"); grid = -1; return; }
        if (hipOccupancyMaxActiveBlocksPerMultiprocessor(&per_cu, (const void*)fwd_megakernel, NTHR, LDS_BYTES) != hipSuccess || per_cu < 1) { fprintf(stderr, "kernel_launch: occupancy query says %d\n", per_cu); grid = -1; return; }
        grid = cus;
    }
    if (grid < 0) return;
    (void)hipMemsetAsync((char*)d_ws + WS_CTL, 0, CTL_ZERO_BYTES, stream);
    Args a{};
    for (int i = 0; i < 27; ++i) a.in[i] = (const float*)d_in[i];
    a.out = (float*)d_out; a.ws = (unsigned char*)d_ws;
    constexpr int NL = MK_N_LAUNCHES;
#ifndef DUP_LAUNCH
#define DUP_LAUNCH -1
#endif
    for (int li = 0; li < NL; ++li)
    for (int rep = 0; rep < ((NL > 1 && li == DUP_LAUNCH) ? 2 : 1); ++rep) {
        if (rep == 1 && li == 0) (void)hipMemsetAsync((char*)d_ws + WS_CTL, 0, CTL_ZERO_BYTES, stream);
        if (rep == 1 && li == 5) (void)hipMemsetAsync((char*)d_ws + WS_SSQ1, 0, MT * 4, stream);
        a.ph_lo = (NL == 1) ? 0 : li; a.ph_hi = (NL == 1) ? N_PHASES : li + 1;
        void* kargs[] = {&a};
        const hipError_t e = hipLaunchCooperativeKernel((const void*)fwd_megakernel, dim3(grid), dim3(NTHR), kargs, LDS_BYTES, stream);
        if (e != hipSuccess) { fprintf(stderr, "kernel_launch: cooperative launch failed: %s\n", hipGetErrorString(e)); break; }
    }
}
```

```cpp
#include <hip/hip_runtime.h>
#include <hip/hip_cooperative_groups.h>
#include <cstdio>
#include <cstdint>
namespace cg = cooperative_groups;
namespace pg8 {
#define PG8_LAS __attribute__((address_space(3)))
typedef unsigned short bf16_t;
typedef short bf16x8 __attribute__((ext_vector_type(8)));
typedef float f32x4 __attribute__((ext_vector_type(4)));
typedef unsigned u32x4 __attribute__((ext_vector_type(4)));
constexpr int BM = 256, BK = 64, HALF = 128, HTB = HALF * BK * 2  , STAGE_BYTES = 8 * HTB, NXCD = 8, WGM = 8;

__host__ __device__ __forceinline__ int lds_byte(int r, int c) { const int st = (r >> 4) * 2 + (c >> 5), rr = r & 15, cc = c & 31, ob = rr * 64 + cc * 2; return st * 1024 + (ob ^ (((ob >> 9) & 1) << 5)); }
__host__ __device__ __forceinline__ void stage_rc(int b, int& R, int& C) { const int st = b / 1024, sb = b % 1024, swz = sb ^ (((sb >> 9) & 1) << 5); R = (st >> 1) * 16 + swz / 64; C = (st & 1) * 32 + (swz % 64) / 2; }
__host__ __device__ __forceinline__ int perm32(int rho) { const int n = rho >> 4, i = rho & 15; return 8 * (i >> 2) + 4 * n + (i & 3); }

struct Unit { int pm, pn; };
struct Gemm { const bf16_t* A; const bf16_t* Bt; int M, N, K; };

struct StaticOrder {
    int nM, nN, nwg, G, c;
    __host__ __device__ void init(int M, int N, int G_, int c_) { nM = M / BM; nN = N / BM; nwg = nM * nN; G = G_; c = c_; }
    __host__ __device__ bool next(int i, Unit& u) const {
        const long L = (long)i * G + c; if (L >= nwg) return false;
        int wgid = (int)L; { const int q = nwg / NXCD, r = nwg % NXCD, xcd = wgid % NXCD, off = wgid / NXCD; wgid = (xcd < r ? xcd * (q + 1) : r * (q + 1) + (xcd - r) * q) + off; }
        const int nig = WGM * nN, gid = wgid / nig, fm = gid * WGM, gsz = (nM - fm) < WGM ? (nM - fm) : WGM;
        u.pm = fm + ((wgid % nig) % gsz); u.pn = (wgid % nig) / gsz; return true;
    }
    __device__ __forceinline__ void a_ready(const Unit&) const {}
    __device__ __forceinline__ void done(const Unit&) const {}
};

__device__ __forceinline__ unsigned cvt_pk_bf16(float lo, float hi) { unsigned r; asm volatile("v_cvt_pk_bf16_f32 %0, %1, %2" : "=v"(r) : "v"(lo), "v"(hi)); return r; }
typedef float f32x2 __attribute__((ext_vector_type(2)));
__device__ __forceinline__ f32x2 gelu_pk(f32x2 v) {
    const f32x2 av = __builtin_elementwise_abs(v), d = av * 0.2316418882f + 1.0f;
    f32x2 t; t.x = __builtin_amdgcn_rcpf(d.x); t.y = __builtin_amdgcn_rcpf(d.y);
    f32x2 q = t * 0.5307027145f + (-0.7265760135f); q = q * t + 0.7107068705f; q = q * t + (-0.142248368f); q = q * t + 0.127414796f; q = q * t;
    const f32x2 s = (v * v) * (-0.72134752044f);
    f32x2 e; e.x = __builtin_amdgcn_exp2f(s.x); e.y = __builtin_amdgcn_exp2f(s.y);
    const f32x2 m = v * (q * e), r = v - m;
    f32x2 o; o.x = v.x < 0.f ? m.x : r.x; o.y = v.y < 0.f ? m.y : r.y; return o;
}

template <int ACT  > struct EpiBf16 {
    static constexpr bool PERM = true, AFTER_DRAIN = false, APERM = false; static_assert(ACT == 0 || ACT == 1, "EpiBf16: ACT is 0 (none) or 1 (gelu_pk)");
    bf16_t* O; int ldc; const float* bias; int split_cols; size_t split_stride; float scale0;
    __device__ __forceinline__ void operator()(const f32x4 (&acc)[2][2][4][2], const Unit& u, int wr, int wc, int fr, int fq) const {
        const int row0 = u.pm * BM + wr * 64 + fr; int colt = u.pn * BM; bf16_t* base = O;
        float sc = 1.f; if (split_cols) { const int t = colt / split_cols; base += (size_t)t * split_stride; colt -= t * split_cols; if (t == 0) sc = scale0; }
        const int col0 = colt + wc * 32 + 8 * fq, bcol0 = u.pn * BM + wc * 32 + 8 * fq;
        f32x4 bv[2][2];
#pragma unroll
        for (int bj = 0; bj < 2; ++bj)
#pragma unroll
            for (int n = 0; n < 2; ++n) bv[bj][n] = bias ? *(const f32x4*)(bias + bcol0 + bj * HALF + 4 * n) : (f32x4){0.f, 0.f, 0.f, 0.f};
#pragma unroll
        for (int ai = 0; ai < 2; ++ai)
#pragma unroll
            for (int m = 0; m < 4; ++m) { bf16_t* rowp = base + (size_t)(row0 + ai * HALF + m * 16) * ldc + col0;
#pragma unroll
                for (int bj = 0; bj < 2; ++bj) { f32x4 v0 = acc[ai][bj][m][0] + bv[bj][0], v1 = acc[ai][bj][m][1] + bv[bj][1];
                    if (ACT == 1) { f32x2 a = gelu_pk((f32x2){v0[0], v0[1]}), b = gelu_pk((f32x2){v0[2], v0[3]}), c = gelu_pk((f32x2){v1[0], v1[1]}), d = gelu_pk((f32x2){v1[2], v1[3]});
                        v0 = (f32x4){a.x, a.y, b.x, b.y}; v1 = (f32x4){c.x, c.y, d.x, d.y}; }
                    v0 = v0 * sc; v1 = v1 * sc; u32x4 w; w.x = cvt_pk_bf16(v0[0], v0[1]); w.y = cvt_pk_bf16(v0[2], v0[3]); w.z = cvt_pk_bf16(v1[0], v1[1]); w.w = cvt_pk_bf16(v1[2], v1[3]);
                    *(u32x4*)(rowp + bj * HALF) = w; } }
    }
};

typedef unsigned u32x2 __attribute__((ext_vector_type(2)));
#define PG8_DPP(oldv, src, ctrl, bc) __builtin_bit_cast(float, __builtin_amdgcn_update_dpp(__builtin_bit_cast(int, (float)(oldv)), __builtin_bit_cast(int, (float)(src)), (ctrl), 0xf, 0xf, (bc)))


__device__ __forceinline__ int na_kappa(int x) { return (x & ~12) | ((x & 8) >> 1) | ((x & 4) << 1); }
struct EpiFragQK {
    static constexpr bool PERM = true, AFTER_DRAIN = false, APERM = false;
    bf16_t* O; float scale_q;
    __device__ __forceinline__ void operator()(const f32x4 (&acc)[2][2][4][2], const Unit& u, int wr, int wc, int fr, int fq) const {
#pragma unroll
        for (int bj = 0; bj < 2; ++bj) { const int col8 = u.pn * BM + bj * HALF + wc * 32 + 8 * fq, which = col8 >> 10, h = (col8 >> 6) & 15, d0 = col8 & 63, ds = d0 >> 4, hh = (d0 >> 3) & 1;
            const float sc = which ? 1.f : scale_q;
#pragma unroll
            for (int ai = 0; ai < 2; ++ai)
#pragma unroll
                for (int m = 0; m < 4; ++m) { const int row = u.pm * BM + ai * HALF + wr * 64 + m * 16 + fr, b = row >> 12, r = (row >> 6) & 63, c = row & 63, t32 = c >> 5, c31 = c & 31;
                    const int rho = which ? na_kappa(c31) : c31;
                    const size_t fi = (((((size_t)(which * 4 + b) * 16 + h) * 64 + r) * 2 + t32) * 4 + ds); const size_t addr = fi * 512 + (rho + 32 * hh) * 8;
                    const f32x4 v0 = acc[ai][bj][m][0] * sc, v1 = acc[ai][bj][m][1] * sc;
                    u32x4 w; w.x = cvt_pk_bf16(v0[0], v0[1]); w.y = cvt_pk_bf16(v0[2], v0[3]); w.z = cvt_pk_bf16(v1[0], v1[1]); w.w = cvt_pk_bf16(v1[2], v1[3]);
                    *(u32x4*)(O + addr) = w; } }
    }
};
struct EpiVHy {
    static constexpr bool PERM = true, AFTER_DRAIN = false, APERM = false;
    bf16_t* O; int ldc;
    __device__ __forceinline__ void operator()(const f32x4 (&acc)[2][2][4][2], const Unit& u, int wr, int wc, int fr, int fq) const {
#pragma unroll
        for (int bj = 0; bj < 2; ++bj) { const int col8 = u.pn * BM + bj * HALF + wc * 32 + 8 * fq, b = col8 >> 12, kr = (col8 >> 6) & 63, c = col8 & 63, kt = c >> 5, s2 = (c >> 4) & 1, hh = (c >> 3) & 1;
#pragma unroll
            for (int ai = 0; ai < 2; ++ai)
#pragma unroll
                for (int m = 0; m < 4; ++m) { const int ch = u.pm * BM + ai * HALF + wr * 64 + m * 16 + fr; size_t addr;
                    if (u.pm < 4) { const int h = ch >> 6, d = ch & 63, dt = d >> 5;
                        const size_t fi = (((((size_t)(b * 16 + h) * 64 + kr) * 2 + kt) * 2 + dt) * 2 + s2); addr = fi * 512 + ((d & 31) + 32 * hh) * 8; }
                    else addr = (size_t)ch * ldc + col8;
                    const f32x4 v0 = acc[ai][bj][m][0], v1 = acc[ai][bj][m][1];
                    u32x4 w; w.x = cvt_pk_bf16(v0[0], v0[1]); w.y = cvt_pk_bf16(v0[2], v0[3]); w.z = cvt_pk_bf16(v1[0], v1[1]); w.w = cvt_pk_bf16(v1[2], v1[3]);
                    *(u32x4*)(O + addr) = w; } }
    }
};
struct EpiRes1 {
    static constexpr bool PERM = true, AFTER_DRAIN = false, APERM = false;
    const float* xin; bf16_t* x1; bf16_t* a2; const float* gate; int gate_stride; const float* gmul; float* ssq; int ldc; PG8_LAS float* gl;
    __device__ __forceinline__ void operator()(const f32x4 (&acc)[2][2][4][2], const Unit& u, int wr, int wc, int fr, int fq) const {
        const int b = u.pm >> 4;
        const int row0 = u.pm * BM + wr * 64 + fr, col0 = u.pn * BM + wc * 32 + 8 * fq;
        PG8_LAS float* glw = gl + (wr * 4 + wc) * 128 + fq * 4;
        {   f32x4 gv[2][2], mv[2][2];
#pragma unroll
            for (int bj = 0; bj < 2; ++bj)
#pragma unroll
                for (int n = 0; n < 2; ++n) { gv[bj][n] = *(const f32x4*)(gate + (size_t)b * gate_stride + col0 + bj * HALF + n * 4); mv[bj][n] = *(const f32x4*)(gmul + (size_t)b * ldc + col0 + bj * HALF + n * 4); }
            if (fr == 0) {
#pragma unroll
                for (int bj = 0; bj < 2; ++bj)
#pragma unroll
                    for (int n = 0; n < 2; ++n) { *(PG8_LAS f32x4*)(glw + (bj * 2 + n) * 16) = gv[bj][n]; *(PG8_LAS f32x4*)(glw + 64 + (bj * 2 + n) * 16) = mv[bj][n]; } }
            asm volatile("s_waitcnt lgkmcnt(0)" ::: "memory");
        }
#ifndef RES1_NS
#define RES1_NS 3
#endif
        f32x4 xv[RES1_NS][2][2]; float sq[4];
#define RES1_LOAD(k_) do { constexpr int ai_ = (k_) >> 2, bj_ = ((k_) >> 1) & 1, mh_ = (k_) & 1; _Pragma("unroll") for (int mm = 0; mm < 2; ++mm) _Pragma("unroll") for (int n = 0; n < 2; ++n) \
            xv[(k_) % RES1_NS][mm][n] = __builtin_nontemporal_load((const f32x4*)(xin + (size_t)(row0 + ai_ * HALF + (2 * mh_ + mm) * 16) * ldc + col0 + bj_ * HALF + n * 4)); asm volatile("" ::: "memory"); } while (0)
#define RES1_PROC(k_) do { constexpr int ai_ = (k_) >> 2, bj_ = ((k_) >> 1) & 1, mh_ = (k_) & 1; u32x4 w1[2], w2[2]; \
            _Pragma("unroll") for (int mm = 0; mm < 2; ++mm) { const int m = 2 * mh_ + mm; float s = bj_ ? sq[m] : 0.f; \
                _Pragma("unroll") for (int n = 0; n < 2; ++n) { const f32x4 v = xv[(k_) % RES1_NS][mm][n] + *(const PG8_LAS f32x4*)(glw + (bj_ * 2 + n) * 16) * acc[ai_][bj_][m][n]; \
                    s += (v[0] * v[0] + v[1] * v[1]) + (v[2] * v[2] + v[3] * v[3]); \
                    const f32x4 a = v * *(const PG8_LAS f32x4*)(glw + 64 + (bj_ * 2 + n) * 16); \
                    if (n == 0) { w1[mm].x = cvt_pk_bf16(v[0], v[1]); w1[mm].y = cvt_pk_bf16(v[2], v[3]); w2[mm].x = cvt_pk_bf16(a[0], a[1]); w2[mm].y = cvt_pk_bf16(a[2], a[3]); } \
                    else { w1[mm].z = cvt_pk_bf16(v[0], v[1]); w1[mm].w = cvt_pk_bf16(v[2], v[3]); w2[mm].z = cvt_pk_bf16(a[0], a[1]); w2[mm].w = cvt_pk_bf16(a[2], a[3]); } } \
                sq[m] = s; } \
            asm volatile("" ::: "memory"); \
            if constexpr ((k_) + RES1_NS < 8) RES1_LOAD((k_) + RES1_NS); \
            _Pragma("unroll") for (int mm = 0; mm < 2; ++mm) { const size_t off = (size_t)(row0 + ai_ * HALF + (2 * mh_ + mm) * 16) * ldc + col0 + bj_ * HALF; *(u32x4*)(x1 + off) = w1[mm]; *(u32x4*)(a2 + off) = w2[mm]; \
                if (bj_) { float s = sq[2 * mh_ + mm]; s += __shfl_xor(s, 16); s += __shfl_xor(s, 32); if (fq == 0) atomicAdd(ssq + row0 + ai_ * HALF + (2 * mh_ + mm) * 16, s); } } \
            asm volatile("" ::: "memory"); } while (0)
        RES1_LOAD(0); RES1_LOAD(1); if constexpr (RES1_NS > 2) RES1_LOAD(2); if constexpr (RES1_NS > 3) RES1_LOAD(3);
        RES1_PROC(0); RES1_PROC(1); RES1_PROC(2); RES1_PROC(3); RES1_PROC(4); RES1_PROC(5); RES1_PROC(6); RES1_PROC(7);
#undef RES1_PROC
#undef RES1_LOAD
    }
};
struct EpiRes2 {
    static constexpr bool PERM = true, AFTER_DRAIN = false, APERM = false;
    const bf16_t* x1; bf16_t* x2; const float* gate; int gate_stride; int ldc;
    __device__ __forceinline__ void operator()(const f32x4 (&acc)[2][2][4][2], const Unit& u, int wr, int wc, int fr, int fq) const {
        const int b = u.pm >> 4;
        const int row0 = u.pm * BM + wr * 64 + fr, col0 = u.pn * BM + wc * 32 + 8 * fq;
        f32x4 gv[2][2];
#pragma unroll
        for (int bj = 0; bj < 2; ++bj)
#pragma unroll
            for (int n = 0; n < 2; ++n) gv[bj][n] = *(const f32x4*)(gate + (size_t)b * gate_stride + col0 + bj * HALF + n * 4);
        u32x4 xw[2][4][2];
#define RES2_LOAD(ai_) do { _Pragma("unroll") for (int m = 0; m < 4; ++m) _Pragma("unroll") for (int bj = 0; bj < 2; ++bj) \
            xw[ai_][m][bj] = __builtin_nontemporal_load((const u32x4*)(x1 + (size_t)(row0 + (ai_) * HALF + m * 16) * ldc + col0 + bj * HALF)); asm volatile("" ::: "memory"); } while (0)
        RES2_LOAD(0); RES2_LOAD(1);
#pragma unroll
        for (int ai = 0; ai < 2; ++ai)
#pragma unroll
            for (int m = 0; m < 4; ++m) { const size_t off = (size_t)(row0 + ai * HALF + m * 16) * ldc + col0;
#pragma unroll
                for (int bj = 0; bj < 2; ++bj) { const u32x4 xq = xw[ai][m][bj];
                    const f32x4 xv0 = {__builtin_bit_cast(float, xq.x << 16), __builtin_bit_cast(float, xq.x & 0xffff0000u), __builtin_bit_cast(float, xq.y << 16), __builtin_bit_cast(float, xq.y & 0xffff0000u)};
                    const f32x4 xv1 = {__builtin_bit_cast(float, xq.z << 16), __builtin_bit_cast(float, xq.z & 0xffff0000u), __builtin_bit_cast(float, xq.w << 16), __builtin_bit_cast(float, xq.w & 0xffff0000u)};
                    const f32x4 v0 = xv0 + gv[bj][0] * acc[ai][bj][m][0], v1 = xv1 + gv[bj][1] * acc[ai][bj][m][1];
                    u32x4 w; w.x = cvt_pk_bf16(v0[0], v0[1]); w.y = cvt_pk_bf16(v0[2], v0[3]); w.z = cvt_pk_bf16(v1[0], v1[1]); w.w = cvt_pk_bf16(v1[2], v1[3]);
                    *(u32x4*)(x2 + off + bj * HALF) = w; }
                asm volatile("" ::: "memory"); }
#undef RES2_LOAD
    }
};
__device__ __forceinline__ f32x2 gelu2s(f32x2 vs) {
    f32x2 t; t.x = __builtin_amdgcn_rcpf(__builtin_fmaf(__builtin_fabsf(vs.x), 0.27273748088f, 1.0f)); t.y = __builtin_amdgcn_rcpf(__builtin_fmaf(__builtin_fabsf(vs.y), 0.27273748088f, 1.0f));
    f32x2 q = t * (-1.061405429f) + 1.453152027f; q = q * t + (-1.421413741f); q = q * t + 0.284496736f; q = q * t + (-0.254829592f); q = q * t;
    const f32x2 s = vs * vs;
    f32x2 e; e.x = __builtin_amdgcn_exp2f(-s.x); e.y = __builtin_amdgcn_exp2f(-s.y);
    const f32x2 h = q * e + 1.0f;
    f32x2 o; o.x = __builtin_fmaf(__builtin_fabsf(vs.x), h.x, vs.x); o.y = __builtin_fmaf(__builtin_fabsf(vs.y), h.y, vs.y); return o;
}

struct EpiGlu {
    static constexpr bool PERM = true, AFTER_DRAIN = false, APERM = true;
    bf16_t* gated; const float* ssq; const float* biasU; const float* cw; const float* cb; float* edgeA; float* edgeB; PG8_LAS float* xch; int ldo;
    __device__ __forceinline__ void operator()(f32x4 (&acc)[2][2][4][2], const Unit& u, int wr, int wc, int fr, int fq) const {
        constexpr float SK = 0.84932180029f, GS = 0.58870501126f;
        const int b = u.pm >> 4;
        const int lcol0 = wc * 32 + 8 * fq, jcol0 = u.pn * HALF + lcol0;
        {
            f32x4 bu[2][2];
#pragma unroll
            for (int bj = 0; bj < 2; ++bj)
#pragma unroll
                for (int n = 0; n < 2; ++n) bu[bj][n] = *(const f32x4*)(biasU + (size_t)b * 11264 + u.pn * BM + bj * HALF + lcol0 + 4 * n);
#pragma unroll
            for (int n = 0; n < 2; ++n) bu[1][n] = bu[1][n] * GS;
#pragma unroll
            for (int ai = 0; ai < 2; ++ai) { const f32x4 q4 = *(const f32x4*)(ssq + u.pm * BM + ai * HALF + wr * 64 + 4 * fr);
#pragma unroll
                for (int m = 0; m < 4; ++m) { const float rs = __builtin_amdgcn_rsqf(q4[m] * (1.0f / 2048.0f) + 1e-6f), rg = rs * GS;
#pragma unroll
                    for (int n = 0; n < 2; ++n) { acc[ai][0][m][n] = acc[ai][0][m][n] * rs + bu[0][n]; acc[ai][1][m][n] = acc[ai][1][m][n] * rg + bu[1][n]; } } }
        }
#pragma unroll
        for (int ai = 0; ai < 2; ++ai) { const int seg = 2 * ai + wr;
#pragma unroll
            for (int n = 0; n < 2; ++n) {
                if (fr == 0) *(PG8_LAS f32x4*)(xch + (seg * 2 + 0) * 128 + lcol0 + 4 * n) = acc[ai][0][0][n];
                if (fr == 15) *(PG8_LAS f32x4*)(xch + (seg * 2 + 1) * 128 + lcol0 + 4 * n) = acc[ai][0][3][n];
            } }
        if (wr == 0) {
            if (fr == 0) {
#pragma unroll
                for (int n = 0; n < 2; ++n) { *(f32x4*)(edgeA + ((size_t)u.pm * 4 + 0) * ldo + jcol0 + 4 * n) = acc[0][0][0][n]; *(f32x4*)(edgeA + ((size_t)u.pm * 4 + 1) * ldo + jcol0 + 4 * n) = acc[0][0][1][n];
                                              *(f32x4*)(edgeB + ((size_t)u.pm * 2 + 0) * ldo + jcol0 + 4 * n) = acc[0][1][0][n] * (1.0f / GS); } }
        } else {
            if (fr == 15) {
#pragma unroll
                for (int n = 0; n < 2; ++n) { *(f32x4*)(edgeA + ((size_t)u.pm * 4 + 2) * ldo + jcol0 + 4 * n) = acc[1][0][2][n]; *(f32x4*)(edgeA + ((size_t)u.pm * 4 + 3) * ldo + jcol0 + 4 * n) = acc[1][0][3][n];
                                              *(f32x4*)(edgeB + ((size_t)u.pm * 2 + 1) * ldo + jcol0 + 4 * n) = acc[1][1][3][n] * (1.0f / GS); } }
        }
        asm volatile("s_waitcnt lgkmcnt(0)" ::: "memory"); __builtin_amdgcn_s_barrier(); asm volatile("" ::: "memory");
        u32x2 w_lo[2][4];
#pragma unroll
        for (int n = 0; n < 2; ++n) {
            const f32x4 w0 = *(const f32x4*)(cw + jcol0 + 4 * n) * SK, w1 = *(const f32x4*)(cw + ldo + jcol0 + 4 * n) * SK, w2 = *(const f32x4*)(cw + 2 * ldo + jcol0 + 4 * n) * SK, cbv = *(const f32x4*)(cb + jcol0 + 4 * n) * SK;
#pragma unroll
            for (int ai = 0; ai < 2; ++ai) { const int seg = 2 * ai + wr;
                f32x4 xp = (f32x4){0.f, 0.f, 0.f, 0.f}, xn = (f32x4){0.f, 0.f, 0.f, 0.f};
                if (seg > 0) xp = *(const PG8_LAS f32x4*)(xch + ((seg - 1) * 2 + 1) * 128 + lcol0 + 4 * n);
                if (seg < 3) xn = *(const PG8_LAS f32x4*)(xch + ((seg + 1) * 2 + 0) * 128 + lcol0 + 4 * n);
#pragma unroll
                for (int e = 0; e < 4; ++e) { xp[e] = PG8_DPP(xp[e], acc[ai][0][3][n][e], 0x111, false);
                                              xn[e] = PG8_DPP(xn[e], acc[ai][0][0][n][e], 0x101, false); }
#pragma unroll
                for (int m = 0; m < 4; ++m) { const f32x4 cur = acc[ai][0][m][n], pv = m > 0 ? acc[ai][0][m > 0 ? m - 1 : 0][n] : xp, nv = m < 3 ? acc[ai][0][m < 3 ? m + 1 : 3][n] : xn;
                    const f32x4 cv = w0 * pv + w1 * cur + w2 * nv + cbv;
                    const f32x2 g0 = gelu2s((f32x2){cv[0], cv[1]}), g1 = gelu2s((f32x2){cv[2], cv[3]});
                    const f32x4 bb = acc[ai][1][m][n];
                    const f32x2 r0 = g0 * (f32x2){bb[0], bb[1]}, r1 = g1 * (f32x2){bb[2], bb[3]};
                    u32x2 w; w.x = cvt_pk_bf16(r0.x, r0.y); w.y = cvt_pk_bf16(r1.x, r1.y);
                    if (n == 0) w_lo[ai][m] = w;
                    else { const int row = u.pm * BM + ai * HALF + wr * 64 + 4 * fr + m;
                        u32x4 o; o.x = w_lo[ai][m].x; o.y = w_lo[ai][m].y; o.z = w.x; o.w = w.y;
                        __builtin_nontemporal_store(o, (u32x4*)(gated + (size_t)row * ldo + jcol0)); } }
            } }
    }
};
#ifdef CLK_PROBE
__device__ unsigned long long pg8_probe_epi;
#endif
template <class Epi, class Sched, bool ALIGN_EPI = false, bool SP2 = false>
__device__ __forceinline__ void gemm_phase(PG8_LAS unsigned char* lds, const Gemm g, const Sched& S, const Epi& E) {
    const int tid = threadIdx.x, wid = __builtin_amdgcn_readfirstlane(tid >> 6), lane = tid & 63, wr = wid >> 2, wc = wid & 3, fr = lane & 15, fq = lane >> 4;
    const int K = g.K, nt = K / BK;
    unsigned voffA[2], voffB[2];
#pragma unroll
    for (int i = 0; i < 2; ++i) { int R, C; stage_rc(tid * 16 + i * 8192, R, C); const int Rb = Epi::PERM ? ((R & ~31) + perm32(R & 31)) : R;
        const int Ra = Epi::APERM ? ((R & ~63) + 4 * (R & 15) + ((R >> 4) & 3)) : R;
        voffA[i] = (unsigned)(Ra * K + C) * 2u; voffB[i] = (unsigned)(Rb * K + C) * 2u; }
    const size_t kstep = (size_t)(BK * 2);
    const size_t hstep = (size_t)HALF * K * 2;
    const size_t tstep = 2 * hstep;
    const unsigned ldsw = (unsigned)wid * 1024u;
    const int aoff = lds_byte(wr * 64 + fr, fq * 8), boff = lds_byte(wc * 32 + fr, fq * 8);
#define PG8_SA(b, h) (((b) * 2 + (h)) * HTB)
#define PG8_SB(b, h) ((4 + (b) * 2 + (h)) * HTB)
#define PG8_STAGE(bufoff, gbase, voff) do { _Pragma("unroll") for (int _i = 0; _i < 2; ++_i) \
        __builtin_amdgcn_global_load_lds((const unsigned*)((const char*)(gbase) + (voff)[_i]), (PG8_LAS unsigned*)(lds + (bufoff) + ldsw + _i * 8192), 16, 0, 0); } while (0)
#define PG8_LDA(dst, b, h) do { _Pragma("unroll") for (int m = 0; m < 4; ++m) _Pragma("unroll") for (int k = 0; k < 2; ++k) dst[m][k] = *(const PG8_LAS bf16x8*)(lds + PG8_SA(b, h) + aoff + m * 2048 + k * 1024); } while (0)
#define PG8_LDB(dst, b, h) do { _Pragma("unroll") for (int n = 0; n < 2; ++n) _Pragma("unroll") for (int k = 0; k < 2; ++k) dst[n][k] = *(const PG8_LAS bf16x8*)(lds + PG8_SB(b, h) + boff + n * 2048 + k * 1024); } while (0)
#define PG8_MMA(ai, bj, At, Bt) do { __builtin_amdgcn_s_setprio(1); _Pragma("unroll") for (int m = 0; m < 4; ++m) _Pragma("unroll") for (int n = 0; n < 2; ++n) _Pragma("unroll") for (int k = 0; k < 2; ++k) \
        acc[ai][bj][m][n] = __builtin_amdgcn_mfma_f32_16x16x32_bf16(Bt[n][k], At[m][k], acc[ai][bj][m][n], 0, 0, 0); __builtin_amdgcn_s_setprio(0); } while (0)
#define PG8_WAIT_V(n) asm volatile("s_waitcnt vmcnt(" #n ")" ::: "memory")
#define PG8_WAIT_L(n) asm volatile("s_waitcnt lgkmcnt(" #n ")" ::: "memory")
#define PG8_BAR __builtin_amdgcn_s_barrier()
#define PG8_SCHED __builtin_amdgcn_sched_barrier(0)
    Unit cur, nxt; int ui = 0;
    if (!S.next(0, cur)) return;
    f32x4 acc[2][2][4][2];
#pragma unroll
    for (int a = 0; a < 2; ++a)
#pragma unroll
        for (int b = 0; b < 2; ++b)
#pragma unroll
            for (int m = 0; m < 4; ++m)
#pragma unroll
                for (int n = 0; n < 2; ++n) acc[a][b][m][n] = (f32x4){0.f, 0.f, 0.f, 0.f};
    bf16x8 At[4][2], B0[2][2], B1[2][2];
    const char* cA = (const char*)g.A + (size_t)cur.pm * tstep; const char* cB = (const char*)g.Bt + (size_t)cur.pn * tstep;
    S.a_ready(cur);
    if constexpr (SP2) {
        PG8_STAGE(PG8_SB(0, 0), cB, voffB); PG8_STAGE(PG8_SB(0, 1), cB + hstep, voffB); PG8_STAGE(PG8_SA(0, 0), cA, voffA); PG8_STAGE(PG8_SA(0, 1), cA + hstep, voffA);
        if (wr == 1) PG8_BAR;
        PG8_WAIT_V(2); PG8_BAR;
        PG8_STAGE(PG8_SB(1, 0), cB + kstep, voffB); PG8_STAGE(PG8_SA(1, 0), cA + kstep, voffA); PG8_STAGE(PG8_SB(1, 1), cB + hstep + kstep, voffB);
        PG8_WAIT_V(6); PG8_BAR;
    } else {
        PG8_STAGE(PG8_SB(0, 0), cB, voffB); PG8_STAGE(PG8_SA(0, 0), cA, voffA); PG8_STAGE(PG8_SB(0, 1), cB + hstep, voffB); PG8_STAGE(PG8_SA(0, 1), cA + hstep, voffA);
        if (wr == 1) PG8_BAR;
        PG8_WAIT_V(4); PG8_BAR;
        PG8_STAGE(PG8_SB(1, 0), cB + kstep, voffB); PG8_STAGE(PG8_SA(1, 0), cA + kstep, voffA); PG8_STAGE(PG8_SB(1, 1), cB + hstep + kstep, voffB);
        PG8_WAIT_V(6); PG8_BAR;
    }
    for (;;) {
        const bool has_next = S.next(ui + 1, nxt);
        const char* nA = has_next ? (const char*)g.A + (size_t)nxt.pm * tstep : cA; const char* nB = has_next ? (const char*)g.Bt + (size_t)nxt.pn * tstep : cB;
#if defined(CLK_PROBE) && CLK_PROBE == 5
        const unsigned long long pr_k0 = __builtin_amdgcn_s_memtime();
#endif
        for (int t = 0; t < nt; t += 2) {
            const bool last = (t == nt - 2);
            const char* a1 = cA + (size_t)(t + 1) * kstep;
            const char* a2 = last ? nA : cA + (size_t)(t + 2) * kstep; const char* b2 = last ? nB : cB + (size_t)(t + 2) * kstep;
            const char* a3 = a2 + kstep; const char* b3 = b2 + kstep;
            if (last && has_next) S.a_ready(nxt);
            if constexpr (SP2) {
            PG8_LDB(B0, 0, 0); PG8_LDB(B1, 0, 1); PG8_SCHED; PG8_LDA(At, 0, 0); PG8_STAGE(PG8_SA(1, 1), a1 + hstep, voffA);
            PG8_WAIT_V(8); PG8_WAIT_L(0); PG8_BAR; PG8_MMA(0, 0, At, B0); PG8_MMA(0, 1, At, B1); PG8_BAR; PG8_SCHED;
            PG8_LDA(At, 0, 1); PG8_STAGE(PG8_SB(0, 0), b2, voffB); PG8_STAGE(PG8_SB(0, 1), b2 + hstep, voffB); PG8_STAGE(PG8_SA(0, 0), a2, voffA);
            PG8_WAIT_V(8); PG8_WAIT_L(0); PG8_BAR; PG8_MMA(1, 0, At, B0); PG8_MMA(1, 1, At, B1); PG8_BAR; PG8_SCHED;
            PG8_LDB(B0, 1, 0); PG8_LDB(B1, 1, 1); PG8_SCHED; PG8_LDA(At, 1, 0); PG8_STAGE(PG8_SA(0, 1), a2 + hstep, voffA);
            PG8_WAIT_V(8); PG8_WAIT_L(0); PG8_BAR; PG8_MMA(0, 0, At, B0); PG8_MMA(0, 1, At, B1); PG8_BAR; PG8_SCHED;
            PG8_LDA(At, 1, 1); PG8_STAGE(PG8_SB(1, 0), b3, voffB); PG8_STAGE(PG8_SB(1, 1), b3 + hstep, voffB); PG8_STAGE(PG8_SA(1, 0), a3, voffA);
            PG8_WAIT_V(8); PG8_WAIT_L(0); PG8_BAR; PG8_MMA(1, 0, At, B0); PG8_MMA(1, 1, At, B1); PG8_BAR; PG8_SCHED;
            } else {
            PG8_LDB(B0, 0, 0); PG8_SCHED; PG8_LDA(At, 0, 0); PG8_STAGE(PG8_SA(1, 1), a1 + hstep, voffA);
            PG8_WAIT_L(8); PG8_BAR; PG8_WAIT_L(0); PG8_MMA(0, 0, At, B0); PG8_BAR; PG8_SCHED;
            PG8_LDB(B1, 0, 1); PG8_STAGE(PG8_SB(0, 0), b2, voffB);
            PG8_BAR; PG8_WAIT_L(0); PG8_MMA(0, 1, At, B1); PG8_BAR;
            PG8_LDA(At, 0, 1); PG8_STAGE(PG8_SA(0, 0), a2, voffA);
            PG8_BAR; PG8_WAIT_L(0); PG8_MMA(1, 0, At, B0); PG8_BAR; PG8_SCHED;
            PG8_STAGE(PG8_SB(0, 1), b2 + hstep, voffB);
            PG8_WAIT_V(6); PG8_BAR; PG8_MMA(1, 1, At, B1); PG8_BAR;
            PG8_LDB(B0, 1, 0); PG8_SCHED; PG8_LDA(At, 1, 0); PG8_STAGE(PG8_SA(0, 1), a2 + hstep, voffA);
            PG8_WAIT_L(8); PG8_BAR; PG8_WAIT_L(0); PG8_MMA(0, 0, At, B0); PG8_BAR; PG8_SCHED;
            PG8_LDB(B1, 1, 1); PG8_STAGE(PG8_SB(1, 0), b3, voffB);
            PG8_BAR; PG8_WAIT_L(0); PG8_MMA(0, 1, At, B1); PG8_BAR;
            PG8_LDA(At, 1, 1); PG8_STAGE(PG8_SA(1, 0), a3, voffA);
            PG8_BAR; PG8_WAIT_L(0); PG8_MMA(1, 0, At, B0); PG8_BAR; PG8_SCHED;
            PG8_STAGE(PG8_SB(1, 1), b3 + hstep, voffB);
            PG8_WAIT_V(6); PG8_BAR; PG8_MMA(1, 1, At, B1); PG8_BAR;
            }
        }
#if defined(CLK_PROBE) && CLK_PROBE == 5
        if (blockIdx.x == 0 && tid == 0) atomicAdd(&pg8_probe_epi, __builtin_amdgcn_s_memtime() - pr_k0);
#endif
        if constexpr (ALIGN_EPI) { if (wr == 0) PG8_BAR; }
#if defined(CLK_PROBE) && CLK_PROBE != 5
        const unsigned long long pr_t0 = __builtin_amdgcn_s_memtime();
#endif
        if constexpr (!Epi::AFTER_DRAIN) { E(acc, cur, wr, wc, fr, fq); S.done(cur); }
#if defined(CLK_PROBE) && CLK_PROBE != 5
        if (blockIdx.x == 0 && tid == 0) atomicAdd(&pg8_probe_epi, __builtin_amdgcn_s_memtime() - pr_t0);
#endif
        if (!has_next) break;
#pragma unroll
        for (int a = 0; a < 2; ++a)
#pragma unroll
            for (int b = 0; b < 2; ++b)
#pragma unroll
                for (int m = 0; m < 4; ++m)
#pragma unroll
                    for (int n = 0; n < 2; ++n) acc[a][b][m][n] = (f32x4){0.f, 0.f, 0.f, 0.f};
        cur = nxt; cA = nA; cB = nB; ++ui;
        if constexpr (ALIGN_EPI) { if (wr == 1) PG8_BAR; }
    }
    PG8_WAIT_V(0);
    if constexpr (!ALIGN_EPI) { if (wr == 0) PG8_BAR; }
    PG8_BAR;
    if constexpr (Epi::AFTER_DRAIN) { E.fused(acc, cur, wr, wc, fr, fq, lds, wid, lane); S.done(cur); }
#undef PG8_SA
#undef PG8_SB
#undef PG8_STAGE
#undef PG8_LDA
#undef PG8_LDB
#undef PG8_MMA
#undef PG8_WAIT_V
#undef PG8_WAIT_L
#undef PG8_BAR
#undef PG8_SCHED
}
}

#ifndef PG8_SP2
#define PG8_SP2 true
#endif
#ifndef PG8_ALIGN
#define PG8_ALIGN true
#endif
#ifndef DUP_MASK
#define DUP_MASK 0
#endif
#ifndef DUP_REPS
#define DUP_REPS 2
#endif
#define DUPN(bit) (((DUP_MASK >> (bit)) & 1) ? DUP_REPS : 1)
#ifndef MK_N_LAUNCHES
#define MK_N_LAUNCHES 1
#endif

constexpr int NB = 4, SEQ = 4096, DM = 2048, MT = NB * SEQ;
constexpr int DNA = 1024, DHY = 1024, NHEAD = 16, DFF = 5632, NMODW = 6 * DM;
constexpr float EPS = 1e-6f;
constexpr int NWAVES = 8, NTHR = 512;
constexpr int N_PHASES = 10;

constexpr size_t MiB = 1u << 20;
constexpr size_t WS_CTL = 0, CTL_ZERO_BYTES = 1 * MiB;
constexpr size_t WS_MOD = 0;
constexpr size_t WS_SSQ1 = 256 * 1024;
constexpr size_t WS_BAR = 512 * 1024;
constexpr size_t WS_BIASU = 1 * MiB;
constexpr size_t WS_GMUL2 = 1 * MiB + 256 * 1024;
constexpr size_t WS_TW = 1 * MiB + 512 * 1024;
constexpr size_t WS_H3 = 2 * MiB;
constexpr size_t WS_WTIN = 4 * MiB;
constexpr size_t WS_WTOUT = 28 * MiB;
constexpr size_t WS_WTUP = 36 * MiB;
constexpr size_t WS_WTDN = 80 * MiB;
constexpr size_t WS_EDGEA = 102 * MiB;
constexpr size_t WS_EDGEB = 108 * MiB;
constexpr size_t WS_H1 = 112 * MiB;
constexpr size_t WS_QK = 176 * MiB;
constexpr size_t WS_VTHY = 240 * MiB;
constexpr size_t WS_GATED = 176 * MiB;
constexpr size_t WS_GT = 368 * MiB;
constexpr size_t WS_NAOUT = 400 * MiB;
constexpr size_t WS_HYOT = 432 * MiB;
constexpr size_t WS_A2 = 400 * MiB;
constexpr size_t WS_END = 464 * MiB;
static_assert(WS_GATED + (size_t)MT * DFF * 2 <= WS_GT && WS_EDGEB + 64ull * 2 * DFF * 4 <= WS_H1 && WS_EDGEA + 64ull * 4 * DFF * 4 <= WS_EDGEB, "ws map");

constexpr int RING_BYTES = 131072;
constexpr int XCH_OFF = RING_BYTES;
constexpr int LDS_BYTES = 163840;
constexpr int BARST_OFF = LDS_BYTES - 64;

#define GAS __attribute__((address_space(1)))
#define LAS __attribute__((address_space(3)))
typedef unsigned short bf16;
typedef unsigned v4u __attribute__((ext_vector_type(4)));
typedef unsigned v2u __attribute__((ext_vector_type(2)));
typedef float f32x4 __attribute__((ext_vector_type(4)));
typedef float f32x2 __attribute__((ext_vector_type(2)));
typedef float f32x16 __attribute__((ext_vector_type(16)));
typedef short bf16x8 __attribute__((ext_vector_type(8)));
typedef short s16x4 __attribute__((ext_vector_type(4)));

__device__ __forceinline__ unsigned f2bf(float f) { unsigned u = __builtin_bit_cast(unsigned, f); return (u + 0x7fffu + ((u >> 16) & 1u)) >> 16; }
__device__ __forceinline__ unsigned pk2(float lo, float hi) { typedef __bf16 bf2v_t __attribute__((ext_vector_type(2))); const f32x2 v = {lo, hi}; return __builtin_bit_cast(unsigned, __builtin_convertvector(v, bf2v_t)); }
__device__ __forceinline__ float bf2f(unsigned short h) { return __builtin_bit_cast(float, (unsigned)h << 16); }
__device__ __forceinline__ float bflo(unsigned w) { return __builtin_bit_cast(float, w << 16); }
__device__ __forceinline__ float bfhi(unsigned w) { return __builtin_bit_cast(float, w & 0xffff0000u); }
__device__ __forceinline__ float wave_sum(float v) {
#pragma unroll
    for (int o = 1; o < 64; o <<= 1) v += __shfl_xor(v, o);
    return v;
}

struct Frame {
    LAS unsigned char* lds;
    int tid, lane, wave, vcu, G;
    const float* const __attribute__((address_space(4)))* in;
    float* out; unsigned char* ws;
};

struct TItem { const float* W; bf16* WT; int K, N, mode, k0, n0; };
constexpr int P0_I_IN = (DM / 64) * (6144 / 32), P0_I_OUT = (DM / 64) * (DM / 32), P0_I_UP = (DM / 64) * (2 * DFF / 32), P0_I_DN = (DFF / 64) * (DM / 32);
constexpr int P0_NITEMS = P0_I_IN + P0_I_OUT + P0_I_UP + P0_I_DN, P0_SPLIT = P0_I_IN + P0_I_OUT;
__device__ __forceinline__ TItem p0_decode(Frame& F, int it) {
    TItem T; int r = it;
    if (r < P0_I_IN) { T.W = F.in[5]; T.WT = (bf16*)(F.ws + WS_WTIN); T.K = DM; T.N = 6144; T.mode = 0; }
    else if ((r -= P0_I_IN) < P0_I_OUT) { T.W = F.in[20]; T.WT = (bf16*)(F.ws + WS_WTOUT); T.K = DM; T.N = DM; T.mode = 1; }
    else if ((r -= P0_I_OUT) < P0_I_UP) { T.W = F.in[22]; T.WT = (bf16*)(F.ws + WS_WTUP); T.K = DM; T.N = 2 * DFF; T.mode = 2; }
    else { r -= P0_I_UP; T.W = F.in[25]; T.WT = (bf16*)(F.ws + WS_WTDN); T.K = DFF; T.N = DM; T.mode = 0; }
    const int nblk = T.N / 32; T.k0 = 64 * (r / nblk); T.n0 = 32 * (r % nblk);
    return T;
}
__device__ __forceinline__ void p0_load(const TItem& T, int lane, f32x4 (&v)[8]) {
#pragma unroll
    for (int i = 0; i < 8; ++i) v[i] = __builtin_nontemporal_load((const f32x4*)(T.W + (size_t)(T.k0 + 8 * i + (lane >> 3)) * T.N + T.n0 + 4 * (lane & 7)));
}
__device__ __forceinline__ void p0_store(const TItem& T, LAS float* scr, int lane, const f32x4 (&v)[8], const float* beta0, const float* beta1) {
#pragma unroll
    for (int i = 0; i < 8; ++i) { LAS float* d = scr + (8 * i + (lane >> 3)) * 33 + 4 * (lane & 7); d[0] = v[i][0]; d[1] = v[i][1]; d[2] = v[i][2]; d[3] = v[i][3]; }
    asm volatile("s_waitcnt lgkmcnt(0)" ::: "memory");
    const int c = lane & 7;
    float sc[8];
#pragma unroll
    for (int i = 0; i < 8; ++i) { sc[i] = 1.f; if (T.mode == 1) { const int k = T.k0 + 8 * c + i; sc[i] = k < 1024 ? beta0[k] : beta1[k - 1024]; } }
#pragma unroll
    for (int j = 0; j < 4; ++j) { const int n = (lane >> 3) + 8 * j; const LAS float* s = scr + (8 * c) * 33 + n;
        v4u o; o.x = pk2(s[0 * 33] * sc[0], s[1 * 33] * sc[1]); o.y = pk2(s[2 * 33] * sc[2], s[3 * 33] * sc[3]); o.z = pk2(s[4 * 33] * sc[4], s[5 * 33] * sc[5]); o.w = pk2(s[6 * 33] * sc[6], s[7 * 33] * sc[7]);
        int row = T.n0 + n;
        if (T.mode == 2) { const int isb = row >= DFF ? 1 : 0, j2 = row - isb * DFF; row = (j2 >> 7) * 256 + isb * 128 + (j2 & 127); }
        *(v4u*)(T.WT + (size_t)row * T.K + T.k0 + 8 * c) = o; }
    asm volatile("s_waitcnt lgkmcnt(0)" ::: "memory");
}
constexpr int P0_SILU_OFF = 114688;
constexpr int P0_MLP_OFF = NWAVES * 64 * 33 * 4;
__device__ __forceinline__ void p0_mlp_pos(Frame& F, int p) {
    const LAS float* w1 = (const LAS float*)(F.lds + P0_MLP_OFF); const LAS float* b1 = w1 + 33 * 64; const LAS float* w2 = b1 + 64; const LAS float* b2 = w2 + 64 * 64;
    const LAS float* w3 = b2 + 64; const LAS float* b3 = w3 + 64 * 64; const LAS float* fq = b3 + 64;
    float* h3 = (float*)(F.ws + WS_H3);
    const float fql = fq[F.lane];
    const float tp = (float)p * (1.0f / 4095.0f), wp = (6.283185307179586f * (float)p) / 4096.0f;
    float z = 0.f;
    if (F.lane == 0) z = tp;
    else if (F.lane <= 16) { const float fr = 1e-4f + (float)(F.lane - 1) * ((15.0f - 1e-4f) / 15.0f); z = __cosf(fr * wp); }
    else if (F.lane <= 32) { const float fr = 1e-4f + (float)(F.lane - 17) * ((15.0f - 1e-4f) / 15.0f); z = -__sinf(fr * wp); }
    float acc = b1[F.lane];
#pragma unroll 11
    for (int i = 0; i < 33; ++i) acc += __builtin_bit_cast(float, __builtin_amdgcn_readlane(__builtin_bit_cast(int, z), i)) * w1[i * 64 + F.lane];
    float h = __sinf(fql * acc);
    acc = b2[F.lane];
#pragma unroll 8
    for (int i = 0; i < 64; ++i) acc += __builtin_bit_cast(float, __builtin_amdgcn_readlane(__builtin_bit_cast(int, h), i)) * w2[i * 64 + F.lane];
    h = __sinf(fql * acc);
    acc = b3[F.lane];
#pragma unroll 8
    for (int i = 0; i < 64; ++i) acc += __builtin_bit_cast(float, __builtin_amdgcn_readlane(__builtin_bit_cast(int, h), i)) * w3[i * 64 + F.lane];
    h = __sinf(fql * acc);
    h3[p * 64 + F.lane] = h;
}

__device__ __forceinline__ void p_convert_late(Frame& F) {
    const int gw = F.vcu * NWAVES + F.wave, NGW = F.G * NWAVES;
    LAS float* scr = (LAS float*)(F.lds + F.wave * (64 * 33 * 4));
    __syncthreads();
    int it = P0_SPLIT + gw; TItem Ta, Tb; f32x4 va[8], vb[8];
    if (it < P0_NITEMS) { Ta = p0_decode(F, it); p0_load(Ta, F.lane, va); }
    while (it < P0_NITEMS) {
        const int it2 = it + NGW; const bool h2 = it2 < P0_NITEMS;
        if (h2) { Tb = p0_decode(F, it2); p0_load(Tb, F.lane, vb); }
        p0_store(Ta, scr, F.lane, va, F.in[18], F.in[19]);
        if (!h2) break;
        const int it3 = it2 + NGW; const bool h3 = it3 < P0_NITEMS;
        if (h3) { Ta = p0_decode(F, it3); p0_load(Ta, F.lane, va); }
        p0_store(Tb, scr, F.lane, vb, F.in[18], F.in[19]);
        if (!h3) break;
        it = it3;
    }
    __syncthreads();
}

__device__ __forceinline__ void p0_prologue(Frame& F) {
    const int gw = F.vcu * NWAVES + F.wave, NGW = F.G * NWAVES;
    {
        LAS float* m = (LAS float*)(F.lds + P0_MLP_OFF);
        {   const float* w1g = F.in[9]; float t1[5];
#pragma unroll
            for (int j = 0; j < 5; ++j) { const int i = F.tid + NTHR * j; t1[j] = w1g[i < 33 * 64 ? i : 0]; }
            asm volatile("" ::: "memory");
#pragma unroll
            for (int j = 0; j < 5; ++j) { const int i = F.tid + NTHR * j; if (i < 33 * 64) m[i] = t1[j]; } }
        for (int i = F.tid; i < 64 * 64; i += NTHR) { m[33 * 64 + 64 + i] = F.in[11][i]; m[33 * 64 + 64 + 64 * 64 + 64 + i] = F.in[13][i]; }
        if (F.tid < 64) { m[33 * 64 + F.tid] = F.in[10][F.tid]; m[33 * 64 + 64 + 64 * 64 + F.tid] = F.in[12][F.tid]; m[33 * 64 + 64 + 64 * 64 + 64 + 64 * 64 + F.tid] = F.in[14][F.tid];
            m[33 * 64 + 64 + 64 * 64 + 64 + 64 * 64 + 64 + F.tid] = F.in[16][F.tid]; }
        {
            LAS float* sl = (LAS float*)(F.lds + P0_SILU_OFF); const float* cvec = F.in[1];
            float cv[16];
#pragma unroll
            for (int j = 0; j < 16; ++j) cv[j] = cvec[F.tid + NTHR * j];
            asm volatile("" ::: "memory");
#pragma unroll
            for (int j = 0; j < 16; ++j) { const int i = F.tid + NTHR * j, b = i >> 11, k = i & 2047; sl[k * 4 + b] = cv[j] / (1.f + __expf(-cv[j])); }
        }
        __syncthreads();
    }
    {
        const float* cvec = F.in[1]; const float* wada = F.in[2]; const float* bada = F.in[3]; float* mod = (float*)(F.ws + WS_MOD);
        LAS float* red = (LAS float*)F.lds;
        const LAS float* sl = (const LAS float*)(F.lds + P0_SILU_OFF);
        auto mload = [&](int task, f32x4 (&w)[16]) { const int strip = task % 48, kbase = (task / 48) * 128 + F.wave * 16;
#pragma unroll
            for (int kk = 0; kk < 16; ++kk) w[kk] = __builtin_nontemporal_load((const f32x4*)(wada + (size_t)(kbase + kk) * NMODW + strip * 256 + F.lane * 4)); };
        auto mtask = [&](int task, const f32x4 (&w)[16]) { const int strip = task % 48, kc = task / 48, kbase = kc * 128 + F.wave * 16;
            f32x4 a0 = {0.f, 0.f, 0.f, 0.f}, a1 = a0, a2 = a0, a3 = a0;
#pragma unroll
            for (int kk = 0; kk < 16; ++kk) { const f32x4 sv = *(const LAS f32x4*)(sl + (kbase + kk) * 4);
                a0 += w[kk] * sv[0]; a1 += w[kk] * sv[1]; a2 += w[kk] * sv[2]; a3 += w[kk] * sv[3]; }
            *(LAS f32x4*)(red + (F.wave * 4 + 0) * 256 + F.lane * 4) = a0; *(LAS f32x4*)(red + (F.wave * 4 + 1) * 256 + F.lane * 4) = a1;
            *(LAS f32x4*)(red + (F.wave * 4 + 2) * 256 + F.lane * 4) = a2; *(LAS f32x4*)(red + (F.wave * 4 + 3) * 256 + F.lane * 4) = a3;
            __syncthreads();
#pragma unroll
            for (int o2 = 0; o2 < 2; ++o2) { const int o = F.tid + 512 * o2, b = o >> 8, col = o & 255; float s = 0.f;
#pragma unroll
                for (int wv = 0; wv < 8; ++wv) s += red[(wv * 4 + b) * 256 + col];
                if (kc == 0) s += bada[strip * 256 + col];
                atomicAdd(mod + b * NMODW + strip * 256 + col, s); }
            __syncthreads(); };
        constexpr int NT = 48 * 16;
        int task = F.vcu; f32x4 wa[16], wb[16];
        if (task < NT) mload(task, wa);
        while (task < NT) {
            const int t2 = task + F.G; const bool h2 = t2 < NT;
            if (h2) mload(t2, wb);
            mtask(task, wa);
            if (!h2) break;
            const int t3 = t2 + F.G; const bool h3 = t3 < NT;
            if (h3) mload(t3, wa);
            mtask(t2, wb);
            if (!h3) break;
            task = t3;
        }
    }
    int mlp_p = gw;
    {
        LAS float* scr = (LAS float*)(F.lds + F.wave * (64 * 33 * 4));
        int it = gw; TItem Ta, Tb; f32x4 va[8], vb[8];
        if (it < P0_SPLIT) { Ta = p0_decode(F, it); p0_load(Ta, F.lane, va); }
        while (it < P0_SPLIT) {
            const int it2 = it + NGW; const bool h2 = it2 < P0_SPLIT;
            if (h2) { Tb = p0_decode(F, it2); p0_load(Tb, F.lane, vb); }
            if (mlp_p < SEQ) { p0_mlp_pos(F, mlp_p); mlp_p += NGW; }
            p0_store(Ta, scr, F.lane, va, F.in[18], F.in[19]);
            if (!h2) break;
            const int it3 = it2 + NGW; const bool h3 = it3 < P0_SPLIT;
            if (h3) { Ta = p0_decode(F, it3); p0_load(Ta, F.lane, va); }
            p0_store(Tb, scr, F.lane, vb, F.in[18], F.in[19]);
            if (!h3) break;
            it = it3;
        }
    }
    for (; mlp_p < SEQ; mlp_p += NGW) p0_mlp_pos(F, mlp_p);
    {
        f32x2* tw = (f32x2*)(F.ws + WS_TW);
        for (int k = F.vcu * NTHR + F.tid; k < 4096; k += F.G * NTHR) { float s, c; sincospif((float)k * (1.0f / 4096.0f), &s, &c); tw[k] = (f32x2){c, -s}; }
    }
}

__device__ __forceinline__ void p_biasu(Frame& F) {
    const int gw = F.vcu * NWAVES + F.wave, NGW = F.G * NWAVES;
    const float* mod = (const float*)(F.ws + WS_MOD);
    const bf16* wt = (const bf16*)(F.ws + WS_WTUP); float* bu = (float*)(F.ws + WS_BIASU);
    f32x4 sh[4][4][2];
#pragma unroll
    for (int b = 0; b < 4; ++b)
#pragma unroll
        for (int j = 0; j < 4; ++j) { const float* p = mod + b * NMODW + 3 * DM + 8 * F.lane + 512 * j; sh[b][j][0] = *(const f32x4*)p; sh[b][j][1] = *(const f32x4*)(p + 4); }
    v4u wn[4];
    if (gw < 2 * DFF) {
#pragma unroll
        for (int j = 0; j < 4; ++j) wn[j] = *(const v4u*)(wt + (size_t)gw * DM + 8 * F.lane + 512 * j); }
#pragma unroll 1
    for (int n = gw; n < 2 * DFF; n += NGW) {
        v4u wc[4];
#pragma unroll
        for (int j = 0; j < 4; ++j) wc[j] = wn[j];
        if (n + NGW < 2 * DFF) {
#pragma unroll
            for (int j = 0; j < 4; ++j) wn[j] = *(const v4u*)(wt + (size_t)(n + NGW) * DM + 8 * F.lane + 512 * j); }
        float sb[4] = {0.f, 0.f, 0.f, 0.f};
#pragma unroll
        for (int j = 0; j < 4; ++j) { const v4u w = wc[j];
            const f32x4 w0 = {bflo(w.x), bfhi(w.x), bflo(w.y), bfhi(w.y)}, w1 = {bflo(w.z), bfhi(w.z), bflo(w.w), bfhi(w.w)};
#pragma unroll
            for (int b = 0; b < 4; ++b) { const f32x4 t = w0 * sh[b][j][0] + w1 * sh[b][j][1]; sb[b] += (t[0] + t[1]) + (t[2] + t[3]); } }
#pragma unroll
        for (int b = 0; b < 4; ++b) sb[b] = wave_sum(sb[b]);
        if (F.lane == 0) { bu[n] = sb[0]; bu[2 * DFF + n] = sb[1]; bu[4 * DFF + n] = sb[2]; bu[6 * DFF + n] = sb[3]; }
    }
}

__device__ __forceinline__ void p_filters(Frame& F) {
    for (int rep = 0; rep < DUPN(13); ++rep) {
        const float* h3 = (const float*)(F.ws + WS_H3); const float* w4 = F.in[15]; float* Gt = (float*)(F.ws + WS_GT);
        LAS float* hT = (LAS float*)F.lds;
        LAS float* wl = (LAS float*)(F.lds + 64 * 132 * 4);
        const int tx = F.tid & 15, ty = F.tid >> 4;
        for (int task = F.vcu; task < 32 * 16; task += F.G) {
            const int p0 = (task & 31) * 128, c0 = (task >> 5) * 128;
            __syncthreads();
#pragma unroll
            for (int it = 0; it < 4; ++it) { const int idx = it * 512 + F.tid, pr = idx >> 4, k4 = (idx & 15) * 4;
                const f32x4 v = *(const f32x4*)(h3 + (size_t)(p0 + pr) * 64 + k4);
                hT[(k4 + 0) * 132 + pr] = v[0]; hT[(k4 + 1) * 132 + pr] = v[1]; hT[(k4 + 2) * 132 + pr] = v[2]; hT[(k4 + 3) * 132 + pr] = v[3]; }
#pragma unroll
            for (int it = 0; it < 4; ++it) { const int idx = it * 512 + F.tid, kr = idx >> 5, c4 = (idx & 31) * 4;
                *(LAS f32x4*)(wl + kr * 128 + c4) = *(const f32x4*)(w4 + (size_t)kr * 2048 + c0 + c4); }
            __syncthreads();
            f32x4 acc[4][2];
#pragma unroll
            for (int i = 0; i < 4; ++i) { acc[i][0] = (f32x4){0.f, 0.f, 0.f, 0.f}; acc[i][1] = (f32x4){0.f, 0.f, 0.f, 0.f}; }
#pragma unroll 8
            for (int k = 0; k < 64; ++k) { const f32x4 a = *(const LAS f32x4*)(hT + k * 132 + 4 * ty), b0 = *(const LAS f32x4*)(wl + k * 128 + 8 * tx), b1 = *(const LAS f32x4*)(wl + k * 128 + 8 * tx + 4);
#pragma unroll
                for (int i = 0; i < 4; ++i) { acc[i][0] += b0 * a[i]; acc[i][1] += b1 * a[i]; } }
            const int pb = p0 + 4 * ty;
            float tp[4];
#pragma unroll
            for (int i = 0; i < 4; ++i) tp[i] = (float)(pb + i) * (1.0f / 4095.0f);
#pragma unroll
            for (int cc = 0; cc < 8; ++cc) { const int col = c0 + 8 * tx + cc, c = col & 1023, bwd = col >> 10;
                const float dmin = -3.0701134573253945f, dmax = -15.350567286626972f;
                const float ad = fabsf(dmin + (float)c * ((dmax - dmin) / 1023.0f));
                f32x4 o;
#pragma unroll
                for (int i = 0; i < 4; ++i) o[i] = acc[i][cc >> 2][cc & 3] * __expf(-tp[i] * ad);
                *(f32x4*)(Gt + (size_t)c * 8192 + bwd * 4096 + pb) = o; }
        }
        __syncthreads();
    }
}

__device__ __forceinline__ void p1_phase(Frame& F) {
    const int gw = F.vcu * NWAVES + F.wave, NGW = F.G * NWAVES;
    const float* mod = (const float*)(F.ws + WS_MOD);
    auto part_a = [&]() {
    for (int rep = 0; rep < DUPN(12); ++rep) {
        const float* x = F.in[0]; const float* g = F.in[4]; bf16* h1 = (bf16*)(F.ws + WS_H1);
        LAS float* mulv = (LAS float*)(F.lds + 81920); LAS float* shv = mulv + NB * DM;
        __syncthreads();
#pragma unroll 4
        for (int i = F.tid; i < NB * DM; i += NTHR) { const int b = i >> 11, k = i & 2047; mulv[i] = g[k] * (1.0f + mod[b * NMODW + DM + k]); shv[i] = mod[b * NMODW + k]; }
        __syncthreads();
        f32x4 v[3][8];
#define P1A_LOAD(i_) do { const f32x4* xr = (const f32x4*)(x + (size_t)(gw + (i_) * NGW) * DM) + F.lane; \
            _Pragma("unroll") for (int j = 0; j < 8; ++j) v[(i_) % 3][j] = __builtin_nontemporal_load(xr + 64 * j); asm volatile("" ::: "memory"); } while (0)
#define P1A_PROC(i_) do { const int m = gw + (i_) * NGW, b = m >> 12; float s = 0.f; \
            _Pragma("unroll") for (int j = 0; j < 8; ++j) { const f32x4 q = v[(i_) % 3][j]; s += (q[0] * q[0] + q[1] * q[1]) + (q[2] * q[2] + q[3] * q[3]); } \
            const float rstd = 1.0f / sqrtf(wave_sum(s) * (1.0f / DM) + EPS); \
            v2u* o = (v2u*)(h1 + (size_t)m * DM) + F.lane; \
            _Pragma("unroll") for (int j = 0; j < 8; ++j) { const int k = 4 * F.lane + 256 * j; \
                const f32x4 rr = v[(i_) % 3][j] * rstd * *(const LAS f32x4*)(mulv + b * DM + k) + *(const LAS f32x4*)(shv + b * DM + k); v2u w; w.x = pk2(rr[0], rr[1]); w.y = pk2(rr[2], rr[3]); o[64 * j] = w; } \
            asm volatile("" ::: "memory"); } while (0)
        static_assert(MT == 8 * 256 * NWAVES, "8 rows per wave");
        P1A_LOAD(0); P1A_LOAD(1);
        P1A_LOAD(2); P1A_PROC(0); P1A_LOAD(3); P1A_PROC(1); P1A_LOAD(4); P1A_PROC(2); P1A_LOAD(5); P1A_PROC(3); P1A_LOAD(6); P1A_PROC(4); P1A_LOAD(7); P1A_PROC(5); P1A_PROC(6); P1A_PROC(7);
        __syncthreads();
#undef P1A_LOAD
#undef P1A_PROC
    }
    };
    auto part_bc = [&]() {
    {
        float* gm = (float*)(F.ws + WS_GMUL2); const float* gf = F.in[21];
        for (int i = F.vcu * NTHR + F.tid; i < NB * DM; i += F.G * NTHR) { const int b = i >> 11, k = i & 2047; gm[i] = gf[k] * (1.0f + mod[b * NMODW + 4 * DM + k]); }
    }
    };
    if (F.vcu & 1) { part_bc(); part_a(); } else { part_a(); part_bc(); }
}

typedef f32x2 cf;
__device__ __forceinline__ cf cmul(cf a, cf b) {
    cf t, r;
    asm("v_pk_mul_f32 %0, %2, %3 op_sel:[0,0] op_sel_hi:[0,1]\n\tv_pk_fma_f32 %1, %2, %3, %0 op_sel:[1,1,0] op_sel_hi:[1,0,1] neg_lo:[1,0,0]" : "=&v"(t), "=v"(r) : "v"(a), "v"(b));
    return r;
}
__device__ __forceinline__ cf cmulc(cf a, cf b) {
    cf t, r;
    asm("v_pk_mul_f32 %0, %2, %3 op_sel:[0,0] op_sel_hi:[0,1] neg_hi:[0,1]\n\tv_pk_fma_f32 %1, %2, %3, %0 op_sel:[1,1,0] op_sel_hi:[1,0,1]" : "=&v"(t), "=v"(r) : "v"(a), "v"(b));
    return r;
}
__device__ __forceinline__ cf cmul2(cf a, cf b, cf c) {
    cf t, r;
    asm("v_pk_mul_f32 %0, %2, %3 op_sel:[0,0] op_sel_hi:[0,1]\n\tv_pk_fma_f32 %1, %2, %3, %0 op_sel:[1,1,0] op_sel_hi:[1,0,1] neg_lo:[1,0,0]\n\t"
        "v_pk_mul_f32 %0, %1, %4 op_sel:[0,0] op_sel_hi:[0,1]\n\tv_pk_fma_f32 %1, %1, %4, %0 op_sel:[1,1,0] op_sel_hi:[1,0,1] neg_lo:[1,0,0]" : "=&v"(t), "=&v"(r) : "v"(a), "v"(b), "v"(c));
    return r;
}
__device__ __forceinline__ cf cmulc2(cf a, cf b, cf c) {
    cf t, r;
    asm("v_pk_mul_f32 %0, %2, %3 op_sel:[0,0] op_sel_hi:[0,1] neg_hi:[0,1]\n\tv_pk_fma_f32 %1, %2, %3, %0 op_sel:[1,1,0] op_sel_hi:[1,0,1]\n\t"
        "v_pk_mul_f32 %0, %1, %4 op_sel:[0,0] op_sel_hi:[0,1] neg_hi:[0,1]\n\tv_pk_fma_f32 %1, %1, %4, %0 op_sel:[1,1,0] op_sel_hi:[1,0,1]" : "=&v"(t), "=&v"(r) : "v"(a), "v"(b), "v"(c));
    return r;
}
template <bool CONJ> __device__ __forceinline__ cf mulc16(cf d, int J) {
    if (J == 0) return d;
    if (J == 4) return CONJ ? (cf){-d.y, d.x} : (cf){d.y, -d.x};
    const float C1 = 0.92387953251128674f, S1 = 0.38268343236508977f, R = 0.70710678118654752f;
    const int K = J & 3;
    const float cr = (K == 1) ? C1 : (K == 2) ? R : S1, ci = (K == 1) ? S1 : (K == 2) ? R : C1;
    cf w, r;
    if (!CONJ) { if (J < 4) { w = (cf){cr, -ci}; r = (cf){ci, cr}; } else { w = (cf){-ci, -cr}; r = (cf){cr, -ci}; } }
    else       { if (J < 4) { w = (cf){cr, ci}; r = (cf){-ci, cr}; } else { w = (cf){-ci, cr}; r = (cf){-cr, -ci}; } }
    return __builtin_elementwise_fma(__builtin_shufflevector(d, d, 1, 1), r, __builtin_shufflevector(d, d, 0, 0) * w);
}
struct Tw { cf w, r; };
__device__ __forceinline__ Tw tw_fwd(cf w) { Tw t; t.w = w; t.r = (cf){-w.y, w.x}; return t; }
__device__ __forceinline__ Tw tw_inv(cf w) { Tw t; t.w = (cf){w.x, -w.y}; t.r = (cf){w.y, w.x}; return t; }
__device__ __forceinline__ cf cmt(cf d, const Tw& t) { return __builtin_elementwise_fma(__builtin_shufflevector(d, d, 1, 1), t.r, __builtin_shufflevector(d, d, 0, 0) * t.w); }
__device__ __forceinline__ cf cmt_rot_fwd(cf d, const Tw& t) { return __builtin_elementwise_fma(__builtin_shufflevector(d, d, 1, 1), t.w, -(__builtin_shufflevector(d, d, 0, 0) * t.r)); }
__device__ __forceinline__ cf cmt_rot_inv(cf d, const Tw& t) { return __builtin_elementwise_fma(__builtin_shufflevector(d, d, 0, 0), t.r, -(__builtin_shufflevector(d, d, 1, 1) * t.w)); }
template <bool CONJ> __device__ __forceinline__ Tw c16tw(int J) {
    const float C1 = 0.92387953251128674f, S1 = 0.38268343236508977f, R = 0.70710678118654752f;
    const float cr = (J == 1) ? C1 : (J == 2) ? R : S1, ci = (J == 1) ? S1 : (J == 2) ? R : C1;
    Tw t; if (!CONJ) { t.w = (cf){cr, -ci}; t.r = (cf){ci, cr}; } else { t.w = (cf){cr, ci}; t.r = (cf){-ci, cr}; }
    return t;
}
template <bool CONJ> __device__ __forceinline__ cf mulc16w_s1(cf d, int J) { return (J & 3) ? cmt(d, c16tw<CONJ>(J & 3)) : d; }
template <bool CONJ> __device__ __forceinline__ cf mulc16w_s2(cf e, int J, const Tw& tw) { return (J < 4) ? cmt(e, tw) : (CONJ ? cmt_rot_inv(e, tw) : cmt_rot_fwd(e, tw)); }
template <bool TW> __device__ __forceinline__ void dif16(cf (&x)[16], cf w1) {
    Tw t1, t2, t4, t8;
    if (TW) { t1 = tw_fwd(w1); const cf w2 = cmt(w1, t1); t2 = tw_fwd(w2); const cf w4 = cmt(w2, t2); t4 = tw_fwd(w4); t8 = tw_fwd(cmt(w4, t4)); }
    cf d[8];
#pragma unroll
    for (int j = 0; j < 8; ++j) { const cf u = x[j], v = x[j + 8]; x[j] = u + v; d[j] = u - v; }
#pragma unroll
    for (int j = 0; j < 8; ++j) d[j] = TW ? mulc16w_s1<false>(d[j], j) : mulc16<false>(d[j], j);
#pragma unroll
    for (int j = 0; j < 8; ++j) x[j + 8] = TW ? mulc16w_s2<false>(d[j], j, t1) : d[j];
#pragma unroll
    for (int q = 0; q < 8; ++q) { const int j = (q & 3) + 8 * (q >> 2); const cf u = x[j], v = x[j + 4]; x[j] = u + v; d[q] = u - v; }
#pragma unroll
    for (int q = 0; q < 8; ++q) d[q] = TW ? mulc16w_s1<false>(d[q], 2 * (q & 3)) : mulc16<false>(d[q], 2 * (q & 3));
#pragma unroll
    for (int q = 0; q < 8; ++q) { const int j = (q & 3) + 8 * (q >> 2); x[j + 4] = TW ? mulc16w_s2<false>(d[q], 2 * (q & 3), t2) : d[q]; }
#pragma unroll
    for (int q = 0; q < 8; ++q) { const int j = (q & 1) + 4 * (q >> 1); const cf u = x[j], v = x[j + 2]; x[j] = u + v; d[q] = u - v; }
#pragma unroll
    for (int q = 0; q < 8; ++q) { const int j = (q & 1) + 4 * (q >> 1); x[j + 2] = TW ? mulc16w_s2<false>(d[q], 4 * (q & 1), t4) : mulc16<false>(d[q], 4 * (q & 1)); }
#pragma unroll
    for (int q = 0; q < 8; ++q) { const int j = 2 * q; const cf u = x[j], v = x[j + 1]; x[j] = u + v; d[q] = u - v; }
#pragma unroll
    for (int q = 0; q < 8; ++q) x[2 * q + 1] = TW ? cmt(d[q], t8) : d[q];
}
template <bool TW> __device__ __forceinline__ void dit16(cf (&x)[16], cf w1) {
    Tw t1, t2, t4, t8;
    if (TW) { const Tw f1 = tw_fwd(w1); const cf w2 = cmt(w1, f1); const Tw f2 = tw_fwd(w2); const cf w4 = cmt(w2, f2); const Tw f4 = tw_fwd(w4); const cf w8 = cmt(w4, f4);
        t1 = tw_inv(w1); t2 = tw_inv(w2); t4 = tw_inv(w4); t8 = tw_inv(w8); }
    cf v[8];
#pragma unroll
    for (int q = 0; q < 8; ++q) v[q] = TW ? cmt(x[2 * q + 1], t8) : x[2 * q + 1];
#pragma unroll
    for (int q = 0; q < 8; ++q) { const int j = 2 * q; const cf u = x[j]; x[j] = u + v[q]; x[j + 1] = u - v[q]; }
#pragma unroll
    for (int q = 0; q < 8; ++q) { const int j = (q & 1) + 4 * (q >> 1); v[q] = TW ? mulc16w_s2<true>(x[j + 2], 4 * (q & 1), t4) : mulc16<true>(x[j + 2], 4 * (q & 1)); }
#pragma unroll
    for (int q = 0; q < 8; ++q) { const int j = (q & 1) + 4 * (q >> 1); const cf u = x[j]; x[j] = u + v[q]; x[j + 2] = u - v[q]; }
#pragma unroll
    for (int q = 0; q < 8; ++q) { const int j = (q & 3) + 8 * (q >> 2); v[q] = TW ? mulc16w_s1<true>(x[j + 4], 2 * (q & 3)) : mulc16<true>(x[j + 4], 2 * (q & 3)); }
#pragma unroll
    for (int q = 0; q < 8; ++q) { if (TW) v[q] = mulc16w_s2<true>(v[q], 2 * (q & 3), t2); }
#pragma unroll
    for (int q = 0; q < 8; ++q) { const int j = (q & 3) + 8 * (q >> 2); const cf u = x[j]; x[j] = u + v[q]; x[j + 4] = u - v[q]; }
#pragma unroll
    for (int j = 0; j < 8; ++j) v[j] = TW ? mulc16w_s1<true>(x[j + 8], j) : mulc16<true>(x[j + 8], j);
#pragma unroll
    for (int j = 0; j < 8; ++j) { if (TW) v[j] = mulc16w_s2<true>(v[j], j, t1); }
#pragma unroll
    for (int j = 0; j < 8; ++j) { const cf u = x[j]; x[j] = u + v[j]; x[j + 8] = u - v[j]; }
}
constexpr int FFT_BUF_BYTES = 9216 * 8;
template <bool INV> __device__ __forceinline__ void fft_pass_a(LAS cf* buf, cf w1, int tid) {
    const int hi = tid >> 8, lo = tid & 255; LAS cf* p = buf + hi * 4608 + lo + 2 * (lo >> 4);
    cf x[16];
#pragma unroll
    for (int j = 0; j < 16; ++j) x[j] = p[288 * j];
    if (INV) dit16<true>(x, w1); else dif16<true>(x, w1);
#pragma unroll
    for (int j = 0; j < 16; ++j) p[288 * j] = x[j];
}
template <bool INV> __device__ __forceinline__ void fft_pass_b(LAS cf* buf, cf w1, int tid) {
    const int blk = tid >> 4, lo = tid & 15; LAS cf* p = buf + blk * 288 + lo;
    cf x[16];
#pragma unroll
    for (int j = 0; j < 16; ++j) x[j] = p[18 * j];
    if (INV) dit16<true>(x, w1); else dif16<true>(x, w1);
#pragma unroll
    for (int j = 0; j < 16; ++j) p[18 * j] = x[j];
}
__device__ __forceinline__ void fft_load_c(const LAS cf* buf, int tid, cf (&x)[16]) {
    const LAS f32x4* p = (const LAS f32x4*)(buf + 18 * tid);
#pragma unroll
    for (int j = 0; j < 8; ++j) { const f32x4 v = p[j]; x[2 * j] = (cf){v[0], v[1]}; x[2 * j + 1] = (cf){v[2], v[3]}; }
}
__device__ __forceinline__ void fft_store_c(LAS cf* buf, int tid, const cf (&x)[16]) {
    LAS f32x4* p = (LAS f32x4*)(buf + 18 * tid);
#pragma unroll
    for (int j = 0; j < 8; ++j) p[j] = (f32x4){x[2 * j].x, x[2 * j].y, x[2 * j + 1].x, x[2 * j + 1].y};
}
struct HyRaw { v4u w; unsigned e; };
__device__ __forceinline__ void hy_load_raw(HyRaw& R, const bf16* row, int t0) {
    R.w = __builtin_nontemporal_load((const v4u*)(row + t0));
    const int lane = threadIdx.x & 63; R.e = 0u;
    if (lane == 0 || lane == 63) R.e = row[lane == 0 ? (t0 > 0 ? t0 - 1 : 0) : (t0 + 8 < SEQ ? t0 + 8 : SEQ - 1)];
}
__device__ __forceinline__ void hy_conv8(const HyRaw& R, int t0, const float (&cw)[4], float (&o)[8]) {
    const v4u w = R.w; float u[10];
    const unsigned hl = (unsigned)__builtin_amdgcn_update_dpp((int)R.e, (int)(w.w >> 16), 0x138, 0xf, 0xf, false);
    const unsigned hr = (unsigned)__builtin_amdgcn_update_dpp((int)R.e, (int)(w.x & 0xffffu), 0x130, 0xf, 0xf, false);
    u[0] = t0 > 0 ? bf2f((unsigned short)hl) : 0.f; u[9] = t0 + 8 < SEQ ? bf2f((unsigned short)hr) : 0.f;
    u[1] = bflo(w.x); u[2] = bfhi(w.x); u[3] = bflo(w.y); u[4] = bfhi(w.y); u[5] = bflo(w.z); u[6] = bfhi(w.z); u[7] = bflo(w.w); u[8] = bfhi(w.w);
#pragma unroll
    for (int e = 0; e < 8; ++e) o[e] = cw[0] * u[e] + cw[1] * u[e + 1] + cw[2] * u[e + 2] + cw[3];
}
__device__ __forceinline__ cf mulsmall(cf w, int e) {
    float c, s;
    switch (e) { case 0: return w; case 1: c = 0.99999970586f; s = 0.00076699032f; break; case 2: c = 0.99999882345f; s = 0.00153398019f; break; case 3: c = 0.99999735277f; s = 0.00230096915f; break;
                 case 4: c = 0.99999529381f; s = 0.00306795676f; break; case 5: c = 0.99999264657f; s = 0.00383494256f; break; case 6: c = 0.99998941108f; s = 0.00460192612f; break; default: c = 0.99998558732f; s = 0.00536890696f; break; }
    Tw t; t.w = (cf){c, -s}; t.r = (cf){s, c};
    return cmt(w, t);
}
struct HyIn { float gq[16]; float wx0[4], wx1[4], wv[4], dbias; v4u wout[4]; int cprev; };
__device__ __forceinline__ void hy_prefetch(Frame& F, int c, HyIn& I) {
    const int tid = F.tid;
    const float* Gt = (const float*)(F.ws + WS_GT) + (size_t)c * 8192;
#pragma unroll
    for (int e = 0; e < 8; ++e) { const int t = tid + 512 * e; I.gq[2 * e] = __builtin_nontemporal_load(Gt + t); const float gb = __builtin_nontemporal_load(Gt + ((8192 - t) & 8191)); I.gq[2 * e + 1] = t ? gb : 0.f; }
    const float* sw = F.in[7]; const float* sb = F.in[8];
    I.wx0[0] = sw[c]; I.wx0[1] = sw[3072 + c]; I.wx0[2] = sw[6144 + c]; I.wx0[3] = sb[c];
    I.wx1[0] = sw[1024 + c]; I.wx1[1] = sw[3072 + 1024 + c]; I.wx1[2] = sw[6144 + 1024 + c]; I.wx1[3] = sb[1024 + c];
    I.wv[0] = sw[2048 + c]; I.wv[1] = sw[3072 + 2048 + c]; I.wv[2] = sw[6144 + 2048 + c]; I.wv[3] = sb[2048 + c];
    I.dbias = F.in[17][c];
    asm volatile("" ::: "memory");
}
template <bool PF_NEXT>
__device__ __forceinline__ void hyena_unit(Frame& F, int c, HyIn& I, int cnext) {
    LAS cf* buf0 = (LAS cf*)F.lds; LAS cf* buf1 = (LAS cf*)(F.lds + FFT_BUF_BYTES);
    const LAS cf* T1 = (const LAS cf*)(F.lds + 2 * FFT_BUF_BYTES); const LAS cf* T8 = T1 + 512;
    const int tid = F.tid, t0 = tid * 8;
    const float* Gt = (const float*)(F.ws + WS_GT) + (size_t)c * 8192;
    const bf16* hyT = (const bf16*)(F.ws + WS_VTHY); bf16* hyo = (bf16*)(F.ws + WS_HYOT);
    const float* sw = F.in[7]; const float* sb = F.in[8];
    const bf16* rx0 = hyT + (size_t)(1024 + c) * MT; const bf16* rx1 = hyT + (size_t)(2048 + c) * MT; const bf16* rv = hyT + (size_t)(3072 + c) * MT;
    const float dbias = I.dbias;
    const cf wa = T1[2 * (tid & 255)], wb = T8[4 * (tid & 15)];
#pragma unroll
    for (int e = 0; e < 8; ++e) { const int t = tid + 512 * e; const float g0 = I.gq[2 * e] + ((e == 0 && tid == 0) ? dbias : 0.f), g1 = I.gq[2 * e + 1]; const cf w = mulc16<false>(T1[tid], e);     const float d = g0 - g1;
        LAS cf* p = buf0 + t + 2 * (t >> 4); p[0] = (cf){g0 + g1, 0.f}; p[4608] = (cf){d * w.x, d * w.y}; }
    __syncthreads();
    HyRaw r1[4], r2[4];
#pragma unroll
    for (int b = 0; b < 4; ++b) { hy_load_raw(r1[b], rx1 + b * SEQ, t0); hy_load_raw(r2[b], rv + b * SEQ, t0); }
    asm volatile("" ::: "memory");
    if (I.cprev >= 0) {
#pragma unroll
        for (int b = 0; b < 4; ++b) *(v4u*)(hyo + (size_t)I.cprev * MT + b * SEQ + t0) = I.wout[b]; }
    fft_pass_a<false>(buf0, wa, tid); __syncthreads();
    fft_pass_b<false>(buf0, wb, tid); __syncthreads();
    cf kf[16];
    fft_load_c(buf0, tid, kf); dif16<false>(kf, (cf){1.f, 0.f});
#pragma unroll
    for (int j = 0; j < 16; ++j) kf[j] = kf[j] * (1.0f / 8192.0f);
    __syncthreads();
    const float wx0[4] = {I.wx0[0], I.wx0[1], I.wx0[2], I.wx0[3]}, wx1[4] = {I.wx1[0], I.wx1[1], I.wx1[2], I.wx1[3]}, wv[4] = {I.wv[0], I.wv[1], I.wv[2], I.wv[3]};
    const int poff = t0 + 2 * (tid >> 1);
    float vv[4][8];
#pragma unroll
    for (int b = 0; b < 4; ++b) { float a[8], v[8]; hy_conv8(r1[b], t0, wx1, a); hy_conv8(r2[b], t0, wv, v);
#pragma unroll
        for (int e = 0; e < 8; ++e) vv[b][e] = a[e] * v[e]; }
#pragma unroll
    for (int e = 0; e < 8; ++e) { const Tw tw = tw_fwd(mulsmall(T8[tid], e)); const cf x0 = (cf){vv[0][e], vv[1][e]}, x1 = (cf){vv[2][e], vv[3][e]};
        buf0[poff + e] = x0; buf0[poff + 4608 + e] = cmt(x0, tw); buf1[poff + e] = x1; buf1[poff + 4608 + e] = cmt(x1, tw); }
    __syncthreads();
    fft_pass_a<false>(buf0, wa, tid); __builtin_amdgcn_sched_barrier(0); fft_pass_a<false>(buf1, wa, tid); __syncthreads();
    fft_pass_b<false>(buf0, wb, tid); __builtin_amdgcn_sched_barrier(0); fft_pass_b<false>(buf1, wb, tid); __syncthreads();
#pragma unroll
    for (int p = 0; p < 2; ++p) { LAS cf* buf = p ? buf1 : buf0; cf x[16]; fft_load_c(buf, tid, x); dif16<false>(x, (cf){1.f, 0.f});
#pragma unroll
        for (int j = 0; j < 16; ++j) x[j] = cmul(x[j], kf[j]);
        dit16<false>(x, (cf){1.f, 0.f}); fft_store_c(buf, tid, x); }
    __syncthreads();
    if constexpr (PF_NEXT) hy_prefetch(F, cnext, I);
    fft_pass_b<true>(buf0, wb, tid); __builtin_amdgcn_sched_barrier(0); fft_pass_b<true>(buf1, wb, tid); __syncthreads();
    HyRaw r0[4];
#pragma unroll
    for (int b = 0; b < 4; ++b) hy_load_raw(r0[b], rx0 + b * SEQ, t0);
    fft_pass_a<true>(buf0, wa, tid); __builtin_amdgcn_sched_barrier(0); fft_pass_a<true>(buf1, wa, tid); __syncthreads();
#pragma unroll
    for (int p = 0; p < 2; ++p) { const LAS cf* buf = p ? buf1 : buf0; cf y[8]; __builtin_amdgcn_sched_barrier(0);
#pragma unroll
        for (int e = 0; e < 8; ++e) y[e] = buf[poff + e] + cmt(buf[poff + 4608 + e], tw_inv(mulsmall(T8[tid], e)));
#pragma unroll
        for (int bb = 0; bb < 2; ++bb) { const int b = 2 * p + bb; float x0[8], o[8];
            hy_conv8(r0[b], t0, wx0, x0);
#pragma unroll
            for (int e = 0; e < 8; ++e) o[e] = (bb == 0 ? y[e].x : y[e].y) * x0[e];
            v4u w; w.x = pk2(o[0], o[1]); w.y = pk2(o[2], o[3]); w.z = pk2(o[4], o[5]); w.w = pk2(o[6], o[7]);
            I.wout[b] = w; } }
    I.cprev = c;
    __syncthreads();
}

#define NA_MFMA(a, b, c) __builtin_amdgcn_mfma_f32_32x32x16_bf16((a), (b), (c), 0, 0, 0)
__device__ __forceinline__ unsigned cvtpk(float lo, float hi) { typedef __bf16 bf2_t __attribute__((ext_vector_type(2))); const f32x2 v = {lo, hi}; const bf2_t b = __builtin_convertvector(v, bf2_t); return __builtin_bit_cast(unsigned, b); }
__device__ __forceinline__ void xhalf(float x, float& a, float& b) { const unsigned u = __builtin_bit_cast(unsigned, x); const auto r = __builtin_amdgcn_permlane32_swap(u, u, false, false); a = __builtin_bit_cast(float, (unsigned)r[0]); b = __builtin_bit_cast(float, (unsigned)r[1]); }
__device__ __forceinline__ void na_tile(const bf16x8 (&kf)[4], const bf16x8 (&vf)[2][2], const LAS unsigned char* qimg, f32x16 (&o)[2][2], float (&mrun)[2], float (&lrun)[2],
                                        const LAS float* brow, int kt, int hh8, const int (&cq)[2], const int (&cs)[2]) {
#pragma unroll
    for (int qt = 0; qt < 2; ++qt) {
        f32x16 s; bf16x8 qf[4];
#pragma unroll
        for (int e = 0; e < 16; ++e) s[e] = 0.f;
#pragma unroll
        for (int ds = 0; ds < 4; ++ds) qf[ds] = *(const LAS bf16x8*)(qimg + (qt * 4 + ds) * 1024);
        const int e0 = (qt != kt) ? 8 * (1 - kt) : 0, e1 = (qt != kt) ? e0 + 8 : 16;
        const int koff = 32 * kt + hh8;
        const LAS float* bp = brow + (koff - cq[qt] + 15);
        float bv[16];
#pragma unroll
        for (int e = 0; e < 16; ++e) if (e >= e0 && e < e1) bv[e] = bp[(e & 3) + 4 * ((e >> 2) & 1) + 16 * (e >> 3)];
        asm volatile("" ::: "memory");
#pragma unroll
        for (int ds = 0; ds < 4; ++ds) s = NA_MFMA(kf[ds], qf[ds], s);
        float mx = -INFINITY;
        const int vlo = koff - cs[qt];
#pragma unroll
        for (int e = 0; e < 16; ++e) if (e >= e0 && e < e1) { const bool valid = (unsigned)(vlo + ((e & 3) + 4 * ((e >> 2) & 1) + 16 * (e >> 3))) < 16u;
            const float v = valid ? s[e] + bv[e] : -INFINITY; s[e] = v; mx = fmaxf(mx, v); }
        { float a_, b_; xhalf(mx, a_, b_); mx = fmaxf(a_, b_); }
        if (__builtin_amdgcn_ballot_w64(mx > mrun[qt] + 8.0f) != 0ull) {
            const float mnew = fmaxf(mrun[qt], mx), ms = (mnew == -INFINITY) ? 0.f : mnew;
            const float alpha = __builtin_amdgcn_exp2f(mrun[qt] - ms);
            lrun[qt] *= alpha; mrun[qt] = mnew;
#pragma unroll
            for (int dt = 0; dt < 2; ++dt)
#pragma unroll
                for (int e = 0; e < 16; ++e) o[dt][qt][e] *= alpha;
        }
        const float msafe = (mrun[qt] == -INFINITY) ? 0.f : mrun[qt];
        float sum = 0.f;
#pragma unroll
        for (int e = 0; e < 16; ++e) if (e >= e0 && e < e1) { const float p = __builtin_amdgcn_exp2f(s[e] - msafe); s[e] = p; sum += p; }
        { float a_, b_; xhalf(sum, a_, b_); sum = a_ + b_; }
        lrun[qt] += sum;
        bf16x8 pf[2];
#pragma unroll
        for (int s2 = 0; s2 < 2; ++s2) if (8 * s2 >= e0 && 8 * s2 < e1) { v4u p; p.x = cvtpk(s[8 * s2 + 0], s[8 * s2 + 1]); p.y = cvtpk(s[8 * s2 + 2], s[8 * s2 + 3]); p.z = cvtpk(s[8 * s2 + 4], s[8 * s2 + 5]); p.w = cvtpk(s[8 * s2 + 6], s[8 * s2 + 7]);
            pf[s2] = __builtin_bit_cast(bf16x8, p); }
#pragma unroll
        for (int dt = 0; dt < 2; ++dt)
#pragma unroll
            for (int s2 = 0; s2 < 2; ++s2) if (8 * s2 >= e0 && 8 * s2 < e1) o[dt][qt] = NA_MFMA(vf[dt][s2], pf[s2], o[dt][qt]);
    }
}
__device__ __forceinline__ void na_load_k(bf16x8 (&kf)[4], const bf16* p) {
#pragma unroll
    for (int ds = 0; ds < 4; ++ds) kf[ds] = *(const bf16x8*)(p + 512 * ds);
}
__device__ __forceinline__ void na_load_v(bf16x8 (&vf)[2][2], const bf16* p) {
#pragma unroll
    for (int dt = 0; dt < 2; ++dt)
#pragma unroll
        for (int s2 = 0; s2 < 2; ++s2) vf[dt][s2] = *(const bf16x8*)(p + 512 * (dt * 2 + s2));
}
__device__ __forceinline__ void na_unit(Frame& F, int unit, LAS float* tab) {
    const int lane = F.lane, c32 = lane & 31, hh = lane >> 5;
    const int r = unit & 63, h = (unit >> 6) & 15, b = unit >> 10;
    const bf16* qkf = (const bf16*)(F.ws + WS_QK); const bf16* vfr = (const bf16*)(F.ws + WS_VTHY); bf16* nao = (bf16*)(F.ws + WS_NAOUT);
    const float* rpb = F.in[6] + h * 465;
    const int rs = min(max(r - 4, 0), 56);
    const size_t mq = (size_t)b * SEQ + r * 64;
    const bf16* qbase = qkf + (((size_t)(b * 16 + h) * 64 + r) * 8) * 512 + lane * 8;
    const bf16* kbase = qkf + (((size_t)((4 + b) * 16 + h) * 64 + rs) * 8) * 512 + lane * 8;
    const bf16* vbase = vfr + (((size_t)(b * 16 + h) * 64 + rs) * 8) * 512 + lane * 8;
    bf16x8 kfA[4], kfB[4], vf[2][2];
    na_load_k(kfA, kbase);
    LAS unsigned char* qimg = (LAS unsigned char*)tab + 2048 + lane * 16;
    float bt[8]; v4u qv[8];
#pragma unroll
    for (int j = 0; j < 8; ++j) { const int i = lane + 64 * j; bt[j] = rpb[i < 465 ? i : 464]; }
#pragma unroll
    for (int f = 0; f < 8; ++f) qv[f] = *(const v4u*)(qbase + 512 * f);
    asm volatile("" ::: "memory");
#pragma unroll
    for (int j = 0; j < 8; ++j) { const int i = lane + 64 * j; if (i < 465) tab[i] = bt[j] * 1.4426950408889634f; }
#pragma unroll
    for (int f = 0; f < 8; ++f) *(LAS v4u*)(qimg + f * 1024) = qv[f];
    f32x16 o[2][2];
#pragma unroll
    for (int dt = 0; dt < 2; ++dt)
#pragma unroll
        for (int qt = 0; qt < 2; ++qt)
#pragma unroll
            for (int e = 0; e < 16; ++e) o[dt][qt][e] = 0.f;
    float mrun[2] = {-INFINITY, -INFINITY}, lrun[2] = {0.f, 0.f};
    int cq[2], cs[2]; int hh8 = 8 * hh;
#pragma unroll
    for (int qt = 0; qt < 2; ++qt) { cq[qt] = 32 * qt + c32; cs[qt] = min(max(cq[qt] - 8, 0), 48); }
#pragma unroll 1
    for (int i = 0; i < 8; ++i) {
        const LAS float* brow = tab + (rs + i - r + 7) * 31;
        na_load_k(kfB, kbase + (size_t)(8 * i + 4) * 512);
        na_load_v(vf, vbase + (size_t)(8 * i) * 512);
        __builtin_amdgcn_sched_barrier(0);
        na_tile(kfA, vf, qimg, o, mrun, lrun, brow, 0, hh8, cq, cs);
        na_load_k(kfA, kbase + (size_t)(8 * (i < 7 ? i + 1 : i)) * 512);
        na_load_v(vf, vbase + (size_t)(8 * i + 4) * 512);
        __builtin_amdgcn_sched_barrier(0);
        na_tile(kfB, vf, qimg, o, mrun, lrun, brow, 1, hh8, cq, cs);
    }
    LAS unsigned char* oimg = (LAS unsigned char*)tab + 2048;
#pragma unroll
    for (int qt = 0; qt < 2; ++qt) { const float inv = 1.0f / lrun[qt]; const int q = 32 * qt + c32;
#pragma unroll
        for (int dt = 0; dt < 2; ++dt)
#pragma unroll
            for (int g = 0; g < 4; ++g) { v2u w; w.x = cvtpk(o[dt][qt][4 * g] * inv, o[dt][qt][4 * g + 1] * inv); w.y = cvtpk(o[dt][qt][4 * g + 2] * inv, o[dt][qt][4 * g + 3] * inv);
                const int d = 32 * dt + 8 * g + 4 * hh;
                *(LAS v2u*)(oimg + q * 128 + ((((d >> 3) ^ (q & 7)) << 4) | ((d & 4) << 1))) = w; } }
    asm volatile("s_waitcnt lgkmcnt(0)" ::: "memory");
#pragma unroll
    for (int it = 0; it < 8; ++it) { const int q = it * 8 + (lane >> 3), ch = lane & 7;
        const v4u w = *(const LAS v4u*)(oimg + q * 128 + ((ch ^ (q & 7)) << 4));
        *(v4u*)(nao + (mq + q) * DNA + h * 64 + 8 * ch) = w; }
    asm volatile("s_waitcnt lgkmcnt(0)" ::: "memory");
}

__device__ __forceinline__ void p3_phase(Frame& F) {
    {
        const f32x2* twg = (const f32x2*)(F.ws + WS_TW); LAS f32x2* T1 = (LAS f32x2*)(F.lds + 2 * FFT_BUF_BYTES);
        T1[F.tid] = twg[F.tid]; T1[512 + F.tid] = twg[8 * F.tid];
        __syncthreads();
    }
#ifndef NO_HYENA
    for (int rep = 0; rep < DUPN(10); ++rep)
    { HyIn I; I.cprev = -1; if (F.vcu < DHY) hy_prefetch(F, F.vcu, I);
#pragma unroll 1
      for (int c = F.vcu; c < DHY; c += F.G) hyena_unit<true>(F, c, I, min(c + F.G, DHY - 1));
      if (I.cprev >= 0) { bf16* hyo = (bf16*)(F.ws + WS_HYOT);
#pragma unroll
        for (int b = 0; b < 4; ++b) *(v4u*)(hyo + (size_t)I.cprev * MT + b * SEQ + F.tid * 8) = I.wout[b]; } }
#endif
#ifndef NO_NA
    LAS float* tab = (LAS float*)(F.lds + F.wave * 10240);
    __syncthreads();
    for (int rep = 0; rep < DUPN(11); ++rep)
    for (int u8 = F.vcu; u8 < (NB * NHEAD * 64) / 8; u8 += F.G) na_unit(F, u8 * 8 + F.wave, tab);
#endif
}

__device__ __forceinline__ void p4_phase(Frame& F) {
    constexpr int PITCH = 1032;
    LAS bf16* tile = (LAS bf16*)F.lds;
    const bf16* hyo = (const bf16*)(F.ws + WS_HYOT); const bf16* nao = (const bf16*)(F.ws + WS_NAOUT); bf16* mg = (bf16*)(F.ws + WS_H1);
    for (int tb = F.vcu; tb < MT / 64; tb += F.G) {
        const int m0 = tb * 64;
#pragma unroll 4
        for (int it = 0; it < 16; ++it) { const int c = it * 64 + (F.tid >> 3), ch = F.tid & 7;
            const v4u w = __builtin_nontemporal_load((const v4u*)(hyo + (size_t)c * MT + m0 + ch * 8));
            LAS bf16* d = tile + (ch * 8) * PITCH + (c ^ (ch << 4));
            d[0] = (bf16)(w.x & 0xffff); d[PITCH] = (bf16)(w.x >> 16); d[2 * PITCH] = (bf16)(w.y & 0xffff); d[3 * PITCH] = (bf16)(w.y >> 16);
            d[4 * PITCH] = (bf16)(w.z & 0xffff); d[5 * PITCH] = (bf16)(w.z >> 16); d[6 * PITCH] = (bf16)(w.w & 0xffff); d[7 * PITCH] = (bf16)(w.w >> 16); }
        __syncthreads();
        for (int tk = F.wave * 8; tk < F.wave * 8 + 8; ++tk) {
            const size_t m = (size_t)m0 + tk;
            {
                const int gsw = (F.lane ^ (tk >> 3)) * 16;
                const v4u w0 = *(const LAS v4u*)(tile + tk * PITCH + gsw), w1 = *(const LAS v4u*)(tile + tk * PITCH + gsw + 8);
                const unsigned ww[8] = {w0.x, w0.y, w0.z, w0.w, w1.x, w1.y, w1.z, w1.w}; float f[16]; float s = 0.f;
#pragma unroll
                for (int e = 0; e < 8; ++e) { f[2 * e] = bflo(ww[e]); f[2 * e + 1] = bfhi(ww[e]); s += f[2 * e] * f[2 * e] + f[2 * e + 1] * f[2 * e + 1]; }
                const float rstd = 1.0f / sqrtf(wave_sum(s) * (1.0f / DHY) + EPS);
                v4u o0, o1; o0.x = pk2(f[0] * rstd, f[1] * rstd); o0.y = pk2(f[2] * rstd, f[3] * rstd); o0.z = pk2(f[4] * rstd, f[5] * rstd); o0.w = pk2(f[6] * rstd, f[7] * rstd);
                o1.x = pk2(f[8] * rstd, f[9] * rstd); o1.y = pk2(f[10] * rstd, f[11] * rstd); o1.z = pk2(f[12] * rstd, f[13] * rstd); o1.w = pk2(f[14] * rstd, f[15] * rstd);
                v4u* dst = (v4u*)(mg + m * DM + DNA + F.lane * 16); dst[0] = o0; dst[1] = o1;
            }
            {
                const v4u* src = (const v4u*)(nao + m * DNA + F.lane * 16); const v4u w0 = __builtin_nontemporal_load(src), w1 = __builtin_nontemporal_load(src + 1);
                const unsigned ww[8] = {w0.x, w0.y, w0.z, w0.w, w1.x, w1.y, w1.z, w1.w}; float f[16]; float s = 0.f;
#pragma unroll
                for (int e = 0; e < 8; ++e) { f[2 * e] = bflo(ww[e]); f[2 * e + 1] = bfhi(ww[e]); s += f[2 * e] * f[2 * e] + f[2 * e + 1] * f[2 * e + 1]; }
                const float rstd = 1.0f / sqrtf(wave_sum(s) * (1.0f / DNA) + EPS);
                v4u o0, o1; o0.x = pk2(f[0] * rstd, f[1] * rstd); o0.y = pk2(f[2] * rstd, f[3] * rstd); o0.z = pk2(f[4] * rstd, f[5] * rstd); o0.w = pk2(f[6] * rstd, f[7] * rstd);
                o1.x = pk2(f[8] * rstd, f[9] * rstd); o1.y = pk2(f[10] * rstd, f[11] * rstd); o1.z = pk2(f[12] * rstd, f[13] * rstd); o1.w = pk2(f[14] * rstd, f[15] * rstd);
                v4u* dst = (v4u*)(mg + m * DM + F.lane * 16); dst[0] = o0; dst[1] = o1;
            }
        }
        __syncthreads();
    }
}

__device__ __forceinline__ void p_fixup_panel(Frame& F, int pm) {
    const float* eA = (const float*)(F.ws + WS_EDGEA); const float* eB = (const float*)(F.ws + WS_EDGEB); bf16* gated = (bf16*)(F.ws + WS_GATED);
    const float* cw = F.in[23]; const float* cb = F.in[24];
    for (int i = F.tid; i < 2 * DFF / 4; i += NTHR) {
        const int bot = i >= DFF / 4 ? 1 : 0, j = 4 * (i - bot * (DFF / 4));
        if (!bot && (pm & 15) == 0) continue;
        if (bot && (pm & 15) == 15) continue;
        f32x4 pv, cv, nv, bv; int row;
        if (!bot) { pv = *(const f32x4*)(eA + ((size_t)(pm - 1) * 4 + 3) * DFF + j); cv = *(const f32x4*)(eA + ((size_t)pm * 4 + 0) * DFF + j); nv = *(const f32x4*)(eA + ((size_t)pm * 4 + 1) * DFF + j); bv = *(const f32x4*)(eB + ((size_t)pm * 2 + 0) * DFF + j); row = pm * 256; }
        else { pv = *(const f32x4*)(eA + ((size_t)pm * 4 + 2) * DFF + j); cv = *(const f32x4*)(eA + ((size_t)pm * 4 + 3) * DFF + j); nv = *(const f32x4*)(eA + ((size_t)(pm + 1) * 4 + 0) * DFF + j); bv = *(const f32x4*)(eB + ((size_t)pm * 2 + 1) * DFF + j); row = pm * 256 + 255; }
        const f32x4 a = *(const f32x4*)(cw + j) * pv + *(const f32x4*)(cw + DFF + j) * cv + *(const f32x4*)(cw + 2 * DFF + j) * nv + *(const f32x4*)(cb + j);
        float g[4];
#pragma unroll
        for (int e = 0; e < 4; ++e) g[e] = 0.5f * a[e] * (1.0f + erff(a[e] * 0.70710678118654752f)) * bv[e];
        v2u w; w.x = pk2(g[0], g[1]); w.y = pk2(g[2], g[3]);
        *(v2u*)(gated + (size_t)row * DFF + j) = w;
    }
}
__device__ __forceinline__ void p_final(Frame& F) {
    const int gw = F.vcu * NWAVES + F.wave, NGW = F.G * NWAVES; const float* g = F.in[26]; const bf16* x2 = (const bf16*)(F.ws + WS_H1);
    for (int m = gw; m < MT; m += NGW) {
        const v4u* xr = (const v4u*)(x2 + (size_t)m * DM) + F.lane; f32x4* orow = (f32x4*)(F.out + (size_t)m * DM); v4u w[4]; float s = 0.f;
#pragma unroll
        for (int j = 0; j < 4; ++j) w[j] = __builtin_nontemporal_load(xr + 64 * j);
        float f[4][8];
#pragma unroll
        for (int j = 0; j < 4; ++j) { f[j][0] = bflo(w[j].x); f[j][1] = bfhi(w[j].x); f[j][2] = bflo(w[j].y); f[j][3] = bfhi(w[j].y); f[j][4] = bflo(w[j].z); f[j][5] = bfhi(w[j].z); f[j][6] = bflo(w[j].w); f[j][7] = bfhi(w[j].w);
#pragma unroll
            for (int e = 0; e < 8; ++e) s += f[j][e] * f[j][e]; }
        const float rstd = 1.0f / sqrtf(wave_sum(s) * (1.0f / DM) + EPS);
#pragma unroll
        for (int j = 0; j < 4; ++j) { const int k = 8 * F.lane + 512 * j; const f32x4 g0 = *(const f32x4*)(g + k), g1 = *(const f32x4*)(g + k + 4);
            __builtin_nontemporal_store((f32x4){f[j][0], f[j][1], f[j][2], f[j][3]} * rstd * g0, orow + (k >> 2)); __builtin_nontemporal_store((f32x4){f[j][4], f[j][5], f[j][6], f[j][7]} * rstd * g1, orow + (k >> 2) + 1); }
    }
}

#define XB_TMO      128
#define XB_XCNT(j)  (256  + 64 * (j))
#define XB_XSUB(j)  (1280 + 64 * (j))
#define XB_XGEN(j)  (2304 + 64 * (j))
#define XB_TOP      3328
#define XB_TOPGEN   3392
#define XCD_BAR_WORDS 3456
#define XB_SPIN_CAP (1u << 18)

__device__ __forceinline__ unsigned xb_ld(unsigned* p)              { return __hip_atomic_load(p, __ATOMIC_RELAXED, __HIP_MEMORY_SCOPE_AGENT); }
__device__ __forceinline__ unsigned xb_add(unsigned* p, unsigned v) { return __hip_atomic_fetch_add(p, v, __ATOMIC_RELAXED, __HIP_MEMORY_SCOPE_AGENT); }
__device__ __forceinline__ unsigned xb_xcc_id() { return (unsigned)__builtin_amdgcn_s_getreg((3 << 11) | 20) & 0xFu; }
#define XB_SPIN(cond, bar) do { unsigned _sp = 0; while (cond) { __builtin_amdgcn_s_sleep(1); \
    if ((++_sp & 255u) == 0u) { if (xb_ld(&(bar)[XB_TMO])) break; if (_sp > XB_SPIN_CAP) { atomicAdd(&(bar)[XB_TMO], 1u); break; } } } } while (0)

struct XcdBarrier {
    unsigned* bar; unsigned x;
    volatile LAS unsigned* st;
};

__device__ __forceinline__ XcdBarrier xcd_barrier_post(unsigned* bar, volatile LAS unsigned* st) {
    XcdBarrier b; b.bar = bar; b.x = xb_xcc_id(); b.st = st;
    if (threadIdx.x == 0) (void)xb_add(&bar[XB_XCNT(b.x)], 1u);
    return b;
}
__device__ __forceinline__ void xcd_barrier_complete(unsigned* bar, unsigned x, unsigned& nloc, unsigned& nx) {
    const unsigned G = gridDim.x * gridDim.y * gridDim.z;
    unsigned sum, cnt, mine, sp = 0u;
    for (;;) {
        sum = 0u; cnt = 0u; mine = 0u;
#pragma unroll
        for (unsigned j = 0; j < 16; ++j) { const unsigned c = xb_ld(&bar[XB_XCNT(j)]); sum += c; cnt += (c > 0u) ? 1u : 0u; mine = (j == x) ? c : mine; }
        if (sum == G) break;
        __builtin_amdgcn_s_sleep(1);
        if ((++sp & 255u) == 0u) { if (xb_ld(&bar[XB_TMO])) break; if (sp > XB_SPIN_CAP) { atomicAdd(&bar[XB_TMO], 1u); break; } }
    }
    nloc = mine > 0u ? mine : 1u; nx = cnt > 0u ? cnt : 1u;
}

__device__ __forceinline__ void xcd_barrier(const XcdBarrier& b) {
    asm volatile("s_waitcnt vmcnt(0)" ::: "memory");
    __syncthreads();
    if (threadIdx.x == 0) {
        unsigned* bar = b.bar;
        __builtin_amdgcn_s_waitcnt(0);
        unsigned nloc = b.st[0], nx = b.st[1];
        if (nloc == 0u) { xcd_barrier_complete(bar, b.x, nloc, nx); b.st[0] = nloc; b.st[1] = nx; }
        const unsigned old = xb_add(&bar[XB_XSUB(b.x)], 1u);
        const unsigned gen = old / nloc;
        if (old + 1u == (gen + 1u) * nloc) {
            __builtin_amdgcn_fence(__ATOMIC_RELEASE, "agent");
            asm volatile("s_waitcnt vmcnt(0)" ::: "memory");
            const unsigned og = xb_add(&bar[XB_TOP], 1u);
            const unsigned tg = og / nx;
            if (og + 1u == (tg + 1u) * nx) xb_add(&bar[XB_TOPGEN], 1u);
            else XB_SPIN(xb_ld(&bar[XB_TOPGEN]) == tg, bar);
            __builtin_amdgcn_fence(__ATOMIC_ACQUIRE, "agent");
            xb_add(&bar[XB_XGEN(b.x)], 1u);
            asm volatile("s_waitcnt vmcnt(0)" ::: "memory");
        } else {
            XB_SPIN(xb_ld(&bar[XB_XGEN(b.x)]) == gen, bar);
            __builtin_amdgcn_fence(__ATOMIC_ACQUIRE, "agent");
            asm volatile("s_waitcnt vmcnt(0)" ::: "memory");
        }
    }
    __syncthreads();
}


struct Args { const float* in[27]; float* out; unsigned char* ws; int ph_lo, ph_hi; };
__global__ void __launch_bounds__(NTHR, 2) fwd_megakernel(Args args) {
    extern __shared__ __attribute__((aligned(16))) unsigned char lds[];
    cg::grid_group grid = cg::this_grid();
    Frame F;
    F.lds = (LAS unsigned char*)lds;
    F.tid = threadIdx.x; F.lane = F.tid & 63; F.wave = __builtin_amdgcn_readfirstlane(F.tid >> 6);
    F.G = gridDim.x; { const int bx = blockIdx.x; F.vcu = (F.G % 8 == 0) ? (bx % 8) * (F.G / 8) + bx / 8 : bx; }
    F.in = (const float* const __attribute__((address_space(4)))*)__builtin_amdgcn_kernarg_segment_ptr();
    F.out = args.out; F.ws = args.ws;
    const int lo = args.ph_lo, hi = args.ph_hi;
#ifndef PHASE_MASK
#define PHASE_MASK 0x3ff
#endif
#define IN(k) (((PHASE_MASK >> (k)) & 1) && lo <= (k) && (k) < hi)
    const bool one_launch = (lo == 0 && hi == N_PHASES);
    volatile LAS unsigned* barst = (volatile LAS unsigned*)(F.lds + BARST_OFF);
    if (F.tid < 2) barst[F.tid] = 0u;
    __syncthreads();
    XcdBarrier bar; bar.bar = (unsigned*)(args.ws + WS_BAR); bar.x = 0; bar.st = barst;
    if (one_launch) bar = xcd_barrier_post((unsigned*)(args.ws + WS_BAR), barst);
#define SEAM(k) do { if (IN(k) && IN((k) + 1)) { if (!one_launch) grid.sync(); else xcd_barrier(bar); } } while (0)
    unsigned char* ws = args.ws;
#ifdef CLK_PROBE
#define STAMP(i) do { if (blockIdx.x == 0 && F.tid == 0) { unsigned long long* tp = (unsigned long long*)(args.ws + WS_CTL + 768 * 1024); tp[2 * (i)] = __builtin_amdgcn_s_memtime(); tp[2 * (i) + 1] = __builtin_amdgcn_s_memrealtime(); tp[64 + (i)] = __hip_atomic_load(&pg8::pg8_probe_epi, __ATOMIC_RELAXED, __HIP_MEMORY_SCOPE_AGENT); } } while (0)
#else
#define STAMP(i) do { } while (0)
#endif
    STAMP(0);
    if (IN(0)) { p0_prologue(F); } SEAM(0);
    STAMP(1);
    if (IN(1)) { for (int rep = 0; rep < DUPN(1); ++rep) p1_phase(F); } SEAM(1);
    STAMP(2);
    if (IN(2)) { if (F.vcu & 1) { p_filters(F); p_convert_late(F); } }
    if (IN(2)) for (int rep = 0; rep < DUPN(2); ++rep) {
        {
            pg8::Gemm g{(const pg8::bf16_t*)(ws + WS_H1), (const pg8::bf16_t*)(ws + WS_WTIN), MT, 2048, DM}; pg8::StaticOrder S; S.init(MT, 2048, F.G, (int)blockIdx.x);
            pg8::EpiFragQK E{(pg8::bf16_t*)(ws + WS_QK), 0.125f * 1.4426950408889634f};
            pg8::gemm_phase<pg8::EpiFragQK, pg8::StaticOrder, PG8_ALIGN, PG8_SP2>(F.lds, g, S, E);
        }
        {
            pg8::Gemm g{(const pg8::bf16_t*)(ws + WS_WTIN) + (size_t)2048 * DM, (const pg8::bf16_t*)(ws + WS_H1), 4096, MT, DM}; pg8::StaticOrder S; S.init(4096, MT, F.G, (int)blockIdx.x);
            pg8::EpiVHy E{(pg8::bf16_t*)(ws + WS_VTHY), MT};
            pg8::gemm_phase<pg8::EpiVHy, pg8::StaticOrder, PG8_ALIGN, PG8_SP2>(F.lds, g, S, E);
        }
    }
    if (IN(2)) { if (!(F.vcu & 1)) { p_filters(F); p_convert_late(F); } }
    SEAM(2);
    STAMP(3);
    if (IN(3)) { p3_phase(F); } SEAM(3);
    STAMP(4);
    if (IN(4)) { for (int rep = 0; rep < DUPN(4); ++rep) p4_phase(F); } SEAM(4);
    STAMP(5);
    if (IN(5)) {
        const float* mod = (const float*)(ws + WS_MOD);
        pg8::Gemm g{(const pg8::bf16_t*)(ws + WS_H1), (const pg8::bf16_t*)(ws + WS_WTOUT), MT, DM, DM}; pg8::StaticOrder S; S.init(MT, DM, F.G, (int)blockIdx.x);
        pg8::EpiRes1 E{F.in[0], (pg8::bf16_t*)F.out, (pg8::bf16_t*)(ws + WS_A2), mod + 2 * DM, NMODW, (const float*)(ws + WS_GMUL2), (float*)(ws + WS_SSQ1), DM, (PG8_LAS float*)(F.lds + XCH_OFF)};
        if (F.vcu & 1) p_biasu(F);
        pg8::gemm_phase<pg8::EpiRes1, pg8::StaticOrder, PG8_ALIGN, PG8_SP2>(F.lds, g, S, E);
        if (!(F.vcu & 1)) p_biasu(F);
    } SEAM(5);
    STAMP(6);
    if (IN(6)) for (int rep = 0; rep < DUPN(6); ++rep) {
        pg8::Gemm g{(const pg8::bf16_t*)(ws + WS_A2), (const pg8::bf16_t*)(ws + WS_WTUP), MT, 2 * DFF, DM}; pg8::StaticOrder S; S.init(MT, 2 * DFF, F.G, (int)blockIdx.x);
        pg8::EpiGlu E{(pg8::bf16_t*)(ws + WS_GATED), (const float*)(ws + WS_SSQ1), (const float*)(ws + WS_BIASU), F.in[23], F.in[24], (float*)(ws + WS_EDGEA), (float*)(ws + WS_EDGEB), (PG8_LAS float*)(F.lds + XCH_OFF), DFF};
        pg8::gemm_phase<pg8::EpiGlu, pg8::StaticOrder, true, PG8_SP2>(F.lds, g, S, E);
    } SEAM(6);
    STAMP(8);
    if (IN(8)) {
        const float* mod = (const float*)(ws + WS_MOD);
        pg8::Gemm g{(const pg8::bf16_t*)(ws + WS_GATED), (const pg8::bf16_t*)(ws + WS_WTDN), MT, DM, DFF}; pg8::StaticOrder S; S.init(MT, DM, F.G, (int)blockIdx.x);
        { pg8::Unit u; int pmdone = -1; for (int i = 0; S.next(i, u); ++i) if (u.pm != pmdone) { p_fixup_panel(F, u.pm); pmdone = u.pm; }
          asm volatile("s_waitcnt vmcnt(0)" ::: "memory"); __syncthreads(); }
        pg8::EpiRes2 E{(const pg8::bf16_t*)F.out, (pg8::bf16_t*)(ws + WS_H1), mod + 5 * DM, NMODW, DM};
        pg8::gemm_phase<pg8::EpiRes2, pg8::StaticOrder, PG8_ALIGN, PG8_SP2>(F.lds, g, S, E);
    } SEAM(8);
    STAMP(9);
    if (IN(9)) { p_final(F); }
#ifdef CLK_PROBE
    STAMP(10); __syncthreads();
    if (blockIdx.x == 0 && F.tid == 0) { const volatile unsigned long long* tp = (const volatile unsigned long long*)(args.ws + WS_CTL + 768 * 1024);
        const double dc = (double)(tp[2 * CLK_B] - tp[2 * CLK_A]), dr = (double)(tp[2 * CLK_B + 1] - tp[2 * CLK_A + 1]);
        const double de = (double)(tp[64 + CLK_B] - tp[64 + CLK_A]);
        const double val = (CLK_PROBE == 1) ? dc / dr * 0.1 * 500.0 : (CLK_PROBE == 3) ? de * (1.0 / 500.0) : dr * 0.01;
        const unsigned long long t0 = __builtin_amdgcn_s_memrealtime(), wait = (unsigned long long)(val * 100.0);
        while (__builtin_amdgcn_s_memrealtime() - t0 < wait) __builtin_amdgcn_s_sleep(8); }
#endif
#undef IN
#undef SEAM
}

extern "C" void kernel_launch(void* const* d_in, const int* in_sizes, int n_in, void* d_out, int out_size, void* d_ws, size_t ws_size, hipStream_t stream) {
    static int grid = 0;
    if (grid == 0) {
        if (n_in != 27 || out_size != MT * DM || ws_size < WS_END) { fprintf(stderr, "kernel_launch: unexpected sizes n_in %d out %d ws %zu\n", n_in, out_size, ws_size); grid = -1; return; }
        int dev = 0, cus = 0, per_cu = 0;
        if (hipGetDevice(&dev) != hipSuccess || hipDeviceGetAttribute(&cus, hipDeviceAttributeMultiprocessorCount, dev) != hipSuccess) { grid = -1; return; }
        if (hipFuncSetAttribute((const void*)fwd_megakernel, hipFuncAttributeMaxDynamicSharedMemorySize, LDS_BYTES) != hipSuccess) { fprintf(stderr, "kernel_launch: hipFuncSetAttribute failed\n"); grid = -1; return; }
        if (hipOccupancyMaxActiveBlocksPerMultiprocessor(&per_cu, (const void*)fwd_megakernel, NTHR, LDS_BYTES) != hipSuccess || per_cu < 1) { fprintf(stderr, "kernel_launch: occupancy query says %d\n", per_cu); grid = -1; return; }
        grid = cus;
    }
    if (grid < 0) return;
    (void)hipMemsetAsync((char*)d_ws + WS_CTL, 0, CTL_ZERO_BYTES, stream);
    Args a{};
    for (int i = 0; i < 27; ++i) a.in[i] = (const float*)d_in[i];
    a.out = (float*)d_out; a.ws = (unsigned char*)d_ws;
    constexpr int NL = MK_N_LAUNCHES;
#ifndef DUP_LAUNCH
#define DUP_LAUNCH -1
#endif
    for (int li = 0; li < NL; ++li)
    for (int rep = 0; rep < ((NL > 1 && li == DUP_LAUNCH) ? 2 : 1); ++rep) {
        if (rep == 1 && li == 0) (void)hipMemsetAsync((char*)d_ws + WS_CTL, 0, CTL_ZERO_BYTES, stream);
        if (rep == 1 && li == 5) (void)hipMemsetAsync((char*)d_ws + WS_SSQ1, 0, MT * 4, stream);
        a.ph_lo = (NL == 1) ? 0 : li; a.ph_hi = (NL == 1) ? N_PHASES : li + 1;
        void* kargs[] = {&a};
        const hipError_t e = hipLaunchCooperativeKernel((const void*)fwd_megakernel, dim3(grid), dim3(NTHR), kargs, LDS_BYTES, stream);
        if (e != hipSuccess) { fprintf(stderr, "kernel_launch: cooperative launch failed: %s\n", hipGetErrorString(e)); break; }
    }
}
```
